# Optimizing an MI355X kernel written in HIP

```python
import jax, jax.numpy as jnp
from jax import lax
import numpy as np

D_MODEL = 1024
BATCH = 8
SEQ = 4096
DEPTH = 2

N_META = 16
EPS = 1e-6
D_FF = 4 * D_MODEL
A_HEADS = 4
A_DQK = D_MODEL // 8
A_DV = D_MODEL // 4
A_CHUNK = 64
B_WIDTH = D_MODEL
B_BLOCKS = 8
B_BLOCK = B_WIDTH // B_BLOCKS
CONV_W = 4
LRU_C = 8.0
C_HEADS = 8
C_Q_LORA = 3 * D_MODEL // 8
C_KV_LORA = D_MODEL // 4
C_NOPE = 64
C_ROPE = 32
C_V = 64
ROPE_THETA = 10000.0
D_HEADS = 8
D_HD = 64
ATT_BLOCK = 128

N_EVEN = (DEPTH + 1) // 2
N_ODD = DEPTH // 2
EVEN_SIZES = (A_HEADS * A_DQK, A_HEADS * A_DQK, A_HEADS * A_DV, A_HEADS * A_DV, A_HEADS, A_HEADS, B_WIDTH, B_WIDTH)
ODD_SIZES = (C_Q_LORA, C_KV_LORA, C_ROPE, D_HEADS * D_HD, D_HEADS * D_HD, D_HEADS * D_HD, D_HEADS)
P_EVEN = sum(EVEN_SIZES)
P_ODD = sum(ODD_SIZES)

kernel_name = "hybrid_mlstm_rglru_mla_fox_trunk"


def rmsnorm(x, g):
    xf = x.astype(jnp.float32)
    y = xf * lax.rsqrt(jnp.mean(xf * xf, axis=-1, keepdims=True) + EPS) * g.astype(jnp.float32)
    return y.astype(x.dtype)


def split_cols(z, sizes):
    out, start = [], 0
    for s in sizes:
        out.append(z[..., start:start + s])
        start += s
    return out


def pad_time(a, n, value=0.0):
    widths = [(0, 0), (0, 0), (n, 0)] + [(0, 0)] * (a.ndim - 3)
    return jnp.pad(a, widths, constant_values=value)


def to_heads(a, n_heads, d):
    b, t, _ = a.shape
    return a.reshape(b, t, n_heads, d).transpose(0, 2, 1, 3)


def from_heads(a):
    b, h, t, d = a.shape
    return a.transpose(0, 2, 1, 3).reshape(b, t, h * d)


def rope(x, pos):
    half = x.shape[-1] // 2
    freqs = ROPE_THETA ** (-jnp.arange(half, dtype=jnp.float32) / half)
    ang = pos[:, None, :, None].astype(jnp.float32) * freqs
    cos, sin = jnp.cos(ang), jnp.sin(ang)
    xf = x.astype(jnp.float32)
    x1, x2 = xf[..., :half], xf[..., half:]
    return jnp.concatenate([x1 * cos - x2 * sin, x1 * sin + x2 * cos], axis=-1).astype(x.dtype)


def mlstm_chunkwise(q, k, v, logi, logf):
    bn, nh, tp, dqk = q.shape
    dv = v.shape[-1]
    nc = tp // A_CHUNK

    def chunks(a):
        a = a.astype(jnp.float32).reshape(bn, nh, nc, A_CHUNK, *a.shape[3:])
        return jnp.moveaxis(a, 2, 0)

    causal = jnp.tril(jnp.ones((A_CHUNK, A_CHUNK), dtype=bool))

    def step(carry, inp):
        c_state, n_state, m_state = carry
        qj, kj, vj, ij, fj = inp
        b = jnp.cumsum(fj, axis=-1)
        dmat = jnp.where(causal, b[..., :, None] - b[..., None, :] + ij[..., None, :], -jnp.inf)
        inter = b + m_state[..., None]
        m_row = jnp.maximum(inter, jnp.max(dmat, axis=-1))
        w_intra = jnp.exp(dmat - m_row[..., None])
        w_inter = jnp.exp(inter - m_row)
        s = jnp.einsum('bhtd,bhsd->bhts', qj, kj) * w_intra
        num = (w_inter[..., None] * jnp.einsum('bhtd,bhde->bhte', qj, c_state)
               + jnp.einsum('bhts,bhse->bhte', s, vj))
        den = w_inter * jnp.einsum('bhtd,bhd->bht', qj, n_state) + jnp.sum(s, axis=-1)
        h = num / jnp.maximum(jnp.abs(den), jnp.exp(-m_row))[..., None]
        g = b[..., -1]
        dk = g[..., None] - b + ij
        m_new = jnp.maximum(g + m_state, jnp.max(dk, axis=-1))
        wk = jnp.exp(dk - m_new[..., None])
        sc = jnp.exp(g + m_state - m_new)
        c_new = sc[..., None, None] * c_state + jnp.einsum('bhs,bhsd,bhse->bhde', wk, kj, vj)
        n_new = sc[..., None] * n_state + jnp.einsum('bhs,bhsd->bhd', wk, kj)
        return (c_new, n_new, m_new), h

    init = (jnp.zeros((bn, nh, dqk, dv), jnp.float32),
            jnp.zeros((bn, nh, dqk), jnp.float32),
            jnp.zeros((bn, nh), jnp.float32))
    _, hs = lax.scan(step, init, (chunks(q), chunks(k), chunks(v), chunks(logi), chunks(logf)))
    return jnp.moveaxis(hs, 0, 2).reshape(bn, nh, tp, dv)


def causal_depthwise_conv(x, w, b):
    k, c = w.shape
    y = lax.conv_general_dilated(x, w[:, None, :], window_strides=(1,), padding=[(k - 1, 0)],
                                 dimension_numbers=('NWC', 'WIO', 'NWC'), feature_group_count=c)
    return y + b


def rglru(x, w_a, b_a, w_x, b_x, lam):
    bn, t, w = x.shape
    xb = x.reshape(bn, t, B_BLOCKS, B_BLOCK)
    r = jax.nn.sigmoid(jnp.einsum('btgi,gij->btgj', xb, w_a).reshape(bn, t, w) + b_a)
    i = jax.nn.sigmoid(jnp.einsum('btgi,gij->btgj', xb, w_x).reshape(bn, t, w) + b_x)
    log_a = -LRU_C * r.astype(jnp.float32) * jax.nn.softplus(-lam.astype(jnp.float32))
    a = jnp.exp(log_a)
    u = jnp.sqrt(-jnp.expm1(2.0 * log_a)) * (i * x).astype(jnp.float32)

    def combine(left, right):
        a1, u1 = left
        a2, u2 = right
        return a1 * a2, a2 * u1 + u2

    _, h = lax.associative_scan(combine, (a, u), axis=1)
    return h.astype(x.dtype)


def blocked_causal_attention(q, k, v, scale, n_pad, fcum=None):
    bn, nh, tp, _ = q.shape
    nb = tp // ATT_BLOCK
    kpos = jnp.arange(tp)
    kvalid = kpos >= n_pad

    def one_block(i):
        start = i * ATT_BLOCK
        qb = lax.dynamic_slice_in_dim(q, start, ATT_BLOCK, axis=2)
        qpos = start + jnp.arange(ATT_BLOCK)
        logits = jnp.einsum('bhqd,bhkd->bhqk', qb, k, preferred_element_type=jnp.float32) * scale
        if fcum is not None:
            fq = lax.dynamic_slice_in_dim(fcum, start, ATT_BLOCK, axis=2)
            logits = logits + (fq[..., :, None] - fcum[..., None, :])
        mask = (kpos[None, :] <= qpos[:, None]) & (kvalid[None, :] | (kpos[None, :] == qpos[:, None]))
        p = jax.nn.softmax(jnp.where(mask, logits, -jnp.inf), axis=-1)
        return jnp.einsum('bhqk,bhkd->bhqd', p.astype(v.dtype), v)

    out = lax.map(one_block, jnp.arange(nb))
    return jnp.moveaxis(out, 0, 2).reshape(bn, nh, tp, v.shape[-1])


def even_mixer(h, ln, w_in, b_if, a_norm_g, conv_w, conv_b, w_ra, b_ra, w_rx, b_rx, lam, w_out):
    bn, t, _ = h.shape
    z = rmsnorm(h, ln) @ w_in
    q, k, v, o, ig, fg, xb, gb = split_cols(z, EVEN_SIZES)
    q = to_heads(q, A_HEADS, A_DQK)
    k = to_heads(k, A_HEADS, A_DQK) * (A_DQK ** -0.5)
    v = to_heads(v, A_HEADS, A_DV)
    gates = (jnp.concatenate([ig, fg], axis=-1) + b_if).astype(jnp.float32)
    logi = gates[..., :A_HEADS].transpose(0, 2, 1)
    logf = jax.nn.log_sigmoid(gates[..., A_HEADS:]).transpose(0, 2, 1)
    pad = A_CHUNK - N_META
    ha = mlstm_chunkwise(pad_time(q, pad), pad_time(k, pad), pad_time(v, pad),
                         pad_time(logi, pad, -jnp.inf), pad_time(logf, pad))[:, :, pad:]
    ha = rmsnorm(ha.astype(h.dtype), a_norm_g) * jax.nn.sigmoid(to_heads(o, A_HEADS, A_DV))
    xc = causal_depthwise_conv(xb, conv_w, conv_b)
    hb = rglru(xc, w_ra, b_ra, w_rx, b_rx, lam) * jax.nn.gelu(gb)
    return jnp.concatenate([from_heads(ha), hb], axis=-1) @ w_out


def odd_mixer(h, pos_full, ln, w_in, b_f, g_qa, g_kva, w_uq, w_ukv, g_qn, g_qr, g_kn, g_kr,
              g_fq, g_fk, w_out):
    bn, t, _ = h.shape
    z = rmsnorm(h, ln) @ w_in
    cq, ckv, kr, fq, fk, fv, ff = split_cols(z, ODD_SIZES)
    pad = ATT_BLOCK - N_META
    q = to_heads(rmsnorm(cq, g_qa) @ w_uq, C_HEADS, C_NOPE + C_ROPE)
    kv = to_heads(rmsnorm(ckv, g_kva) @ w_ukv, C_HEADS, C_NOPE + C_V)
    q_nope = rmsnorm(q[..., :C_NOPE], g_qn)
    q_rope = rope(rmsnorm(q[..., C_NOPE:], g_qr), pos_full)
    k_nope = rmsnorm(kv[..., :C_NOPE], g_kn)
    k_rope = rope(rmsnorm(kr, g_kr)[:, None], pos_full)
    q_mla = jnp.concatenate([q_nope, q_rope], axis=-1)
    k_mla = jnp.concatenate([k_nope, jnp.broadcast_to(k_rope, (bn, C_HEADS, t, C_ROPE))], axis=-1)
    v_mla = kv[..., C_NOPE:]
    hc = blocked_causal_attention(pad_time(q_mla, pad), pad_time(k_mla, pad), pad_time(v_mla, pad),
                                  (C_NOPE + C_ROPE) ** -0.5, pad)[:, :, pad:]
    qf = rmsnorm(to_heads(fq, D_HEADS, D_HD), g_fq)
    kf = rmsnorm(to_heads(fk, D_HEADS, D_HD), g_fk)
    vf = to_heads(fv, D_HEADS, D_HD)
    logf = jax.nn.log_sigmoid((ff + b_f).astype(jnp.float32)).transpose(0, 2, 1)
    fcum = jnp.cumsum(pad_time(logf, pad), axis=-1)
    hd = blocked_causal_attention(pad_time(qf, pad), pad_time(kf, pad), pad_time(vf, pad),
                                  D_HD ** -0.5, pad, fcum)[:, :, pad:]
    return jnp.concatenate([from_heads(hc), from_heads(hd)], axis=-1) @ w_out


def sqrelu_mlp(h, ln, w1, w2):
    return jnp.square(jax.nn.relu(rmsnorm(h, ln) @ w1)) @ w2


def setup_inputs(seed: int = 0) -> dict:
    key = jax.random.key(seed)
    ks = iter(jax.random.split(key, 48))
    nrm = lambda shape, s: jax.random.normal(next(ks), shape, jnp.float32) * s
    gain = lambda shape: 1.0 + nrm(shape, 0.02)
    ne, no = N_EVEN, N_ODD
    x = jax.random.normal(next(ks), (BATCH, SEQ, D_MODEL), jnp.float32)
    positions = (jnp.arange(SEQ, dtype=jnp.int32)[None, :]
                 + jax.random.randint(next(ks), (BATCH, 1), 0, 1024, dtype=jnp.int32))
    meta = nrm((N_META, D_MODEL), 1.0)
    ev_ln = gain((ne, D_MODEL))
    ev_w_in = nrm((ne, D_MODEL, P_EVEN), D_MODEL ** -0.5)
    ev_b_if = jnp.concatenate([nrm((ne, A_HEADS), 0.1),
                               3.0 + 3.0 * jax.random.uniform(next(ks), (ne, A_HEADS))], axis=-1)
    ev_a_norm = gain((ne, A_DV))
    ev_conv_w = nrm((ne, CONV_W, B_WIDTH), CONV_W ** -0.5)
    ev_conv_b = nrm((ne, B_WIDTH), 0.01)
    ev_w_ra = nrm((ne, B_BLOCKS, B_BLOCK, B_BLOCK), B_BLOCK ** -0.5)
    ev_b_ra = nrm((ne, B_WIDTH), 0.01)
    ev_w_rx = nrm((ne, B_BLOCKS, B_BLOCK, B_BLOCK), B_BLOCK ** -0.5)
    ev_b_rx = nrm((ne, B_WIDTH), 0.01)
    a0 = jax.random.uniform(next(ks), (ne, B_WIDTH), jnp.float32, 0.9, 0.999)
    s0 = a0 ** (1.0 / LRU_C)
    ev_lam = jnp.log(s0) - jnp.log1p(-s0)
    ev_w_out = nrm((ne, A_HEADS * A_DV + B_WIDTH, D_MODEL), (A_HEADS * A_DV + B_WIDTH) ** -0.5)
    od_ln = gain((no, D_MODEL))
    od_w_in = nrm((no, D_MODEL, P_ODD), D_MODEL ** -0.5)
    od_b_f = 2.0 + nrm((no, D_HEADS), 0.5)
    od_g_qa = gain((no, C_Q_LORA))
    od_g_kva = gain((no, C_KV_LORA))
    od_w_uq = nrm((no, C_Q_LORA, C_HEADS * (C_NOPE + C_ROPE)), C_Q_LORA ** -0.5)
    od_w_ukv = nrm((no, C_KV_LORA, C_HEADS * (C_NOPE + C_V)), C_KV_LORA ** -0.5)
    od_g_qn = gain((no, C_NOPE))
    od_g_qr = gain((no, C_ROPE))
    od_g_kn = gain((no, C_NOPE))
    od_g_kr = gain((no, C_ROPE))
    od_g_fq = gain((no, D_HD))
    od_g_fk = gain((no, D_HD))
    od_w_out = nrm((no, C_HEADS * C_V + D_HEADS * D_HD, D_MODEL), (C_HEADS * C_V + D_HEADS * D_HD) ** -0.5)
    mlp_ln = gain((DEPTH, D_MODEL))
    w_ff1 = nrm((DEPTH, D_MODEL, D_FF), D_MODEL ** -0.5)
    w_ff2 = nrm((DEPTH, D_FF, D_MODEL), D_FF ** -0.5)
    return {"x": x, "positions": positions, "meta": meta,
            "ev_ln": ev_ln, "ev_w_in": ev_w_in, "ev_b_if": ev_b_if, "ev_a_norm": ev_a_norm,
            "ev_conv_w": ev_conv_w, "ev_conv_b": ev_conv_b, "ev_w_ra": ev_w_ra, "ev_b_ra": ev_b_ra,
            "ev_w_rx": ev_w_rx, "ev_b_rx": ev_b_rx, "ev_lam": ev_lam, "ev_w_out": ev_w_out,
            "od_ln": od_ln, "od_w_in": od_w_in, "od_b_f": od_b_f, "od_g_qa": od_g_qa,
            "od_g_kva": od_g_kva, "od_w_uq": od_w_uq, "od_w_ukv": od_w_ukv, "od_g_qn": od_g_qn,
            "od_g_qr": od_g_qr, "od_g_kn": od_g_kn, "od_g_kr": od_g_kr, "od_g_fq": od_g_fq,
            "od_g_fk": od_g_fk, "od_w_out": od_w_out,
            "mlp_ln": mlp_ln, "w_ff1": w_ff1, "w_ff2": w_ff2}


def reference(x, positions, meta,
              ev_ln, ev_w_in, ev_b_if, ev_a_norm, ev_conv_w, ev_conv_b, ev_w_ra, ev_b_ra,
              ev_w_rx, ev_b_rx, ev_lam, ev_w_out,
              od_ln, od_w_in, od_b_f, od_g_qa, od_g_kva, od_w_uq, od_w_ukv, od_g_qn, od_g_qr,
              od_g_kn, od_g_kr, od_g_fq, od_g_fk, od_w_out,
              mlp_ln, w_ff1, w_ff2):
    bn = x.shape[0]
    h = jnp.concatenate([jnp.broadcast_to(meta.astype(x.dtype), (bn, N_META, D_MODEL)), x], axis=1)
    meta_pos = jnp.broadcast_to(jnp.arange(N_META, dtype=jnp.int32)[None, :], (bn, N_META))
    pos_full = jnp.concatenate([meta_pos, positions + N_META], axis=1)
    for layer in range(DEPTH):
        if layer % 2 == 0:
            e = layer // 2
            h = h + even_mixer(h, ev_ln[e], ev_w_in[e], ev_b_if[e], ev_a_norm[e], ev_conv_w[e],
                               ev_conv_b[e], ev_w_ra[e], ev_b_ra[e], ev_w_rx[e], ev_b_rx[e],
                               ev_lam[e], ev_w_out[e])
        else:
            o = layer // 2
            h = h + odd_mixer(h, pos_full, od_ln[o], od_w_in[o], od_b_f[o], od_g_qa[o], od_g_kva[o],
                              od_w_uq[o], od_w_ukv[o], od_g_qn[o], od_g_qr[o], od_g_kn[o],
                              od_g_kr[o], od_g_fq[o], od_g_fk[o], od_w_out[o])
        h = h + sqrelu_mlp(h, mlp_ln[layer], w_ff1[layer], w_ff2[layer])
    return h[:, N_META:]
```

```cpp
#include <hip/hip_runtime.h>
#include <hip/hip_cooperative_groups.h>
#include <cstdio>
#include <cstdint>
namespace cg = cooperative_groups;
namespace pg8 {
#define PG8_LAS __attribute__((address_space(3)))
typedef unsigned short bf16_t;
typedef short bf16x8 __attribute__((ext_vector_type(8)));
typedef float f32x4 __attribute__((ext_vector_type(4)));
typedef unsigned u32x4 __attribute__((ext_vector_type(4)));
constexpr int BM = 256, BK = 64, HALF = 128, HTB = HALF * BK * 2  , STAGE_BYTES = 8 * HTB, NXCD = 8, WGM = 8;

__host__ __device__ __forceinline__ int lds_byte(int r, int c) { const int st = (r >> 4) * 2 + (c >> 5), rr = r & 15, cc = c & 31, ob = rr * 64 + cc * 2; return st * 1024 + (ob ^ (((ob >> 9) & 1) << 5)); }
__host__ __device__ __forceinline__ void stage_rc(int b, int& R, int& C) { const int st = b / 1024, sb = b % 1024, swz = sb ^ (((sb >> 9) & 1) << 5); R = (st >> 1) * 16 + swz / 64; C = (st & 1) * 32 + (swz % 64) / 2; }
__host__ __device__ __forceinline__ int perm32(int rho) { const int n = rho >> 4, i = rho & 15; return 8 * (i >> 2) + 4 * n + (i & 3); }

struct Unit { int pm, pn; };
struct Gemm { const bf16_t* A; const bf16_t* Bt; int M, N, K, lda, ldb; };

struct StaticOrder {
    int nM, nN, nwg, G, c;
    __host__ __device__ void init(int M, int N, int G_, int c_) { nM = M / BM; nN = N / BM; nwg = nM * nN; G = G_; c = c_; }
    __host__ __device__ bool next(int i, Unit& u) const {
        const long L = (long)i * G + c; if (L >= nwg) return false;
        int wgid = (int)L; { const int q = nwg / NXCD, r = nwg % NXCD, xcd = wgid % NXCD, off = wgid / NXCD; wgid = (xcd < r ? xcd * (q + 1) : r * (q + 1) + (xcd - r) * q) + off; }
        const int nig = WGM * nN, gid = wgid / nig, fm = gid * WGM, gsz = (nM - fm) < WGM ? (nM - fm) : WGM;
        u.pm = fm + ((wgid % nig) % gsz); u.pn = (wgid % nig) / gsz; return true;
    }
    __device__ __forceinline__ void a_ready(const Unit&) const {}
    __device__ __forceinline__ void done(const Unit&) const {}
};
}
using pg8::bf16_t; using pg8::bf16x8; using pg8::f32x4;
#define DEVI __device__ __forceinline__

constexpr int T = 4112, NB = 8, M = NB * T, MP = 33024, NT = 512;
constexpr float EPS = 1e-6f;
constexpr float LOG2E = 1.4426950408889634f;

struct Params {
  const float *x; const int* pos; const float* meta;
  const float *ev_ln, *ev_w_in, *ev_b_if, *ev_a_norm, *ev_conv_w, *ev_conv_b, *ev_w_ra, *ev_b_ra, *ev_w_rx, *ev_b_rx, *ev_lam, *ev_w_out;
  const float *od_ln, *od_w_in, *od_b_f, *od_g_qa, *od_g_kva, *od_w_uq, *od_w_ukv, *od_g_qn, *od_g_qr, *od_g_kn, *od_g_kr, *od_g_fq, *od_g_fk, *od_w_out;
  const float *mlp_ln, *w_ff1, *w_ff2;
  float* out; unsigned char* ws;
};

constexpr size_t OFF_WINE  = 0;
constexpr size_t OFF_WOUTE = OFF_WINE + (size_t)5376 * 1024 * 2;
constexpr size_t OFF_FF1   = OFF_WOUTE + (size_t)1024 * 2048 * 2;
constexpr size_t OFF_FF2   = OFF_FF1 + (size_t)2 * 4096 * 1024 * 2;
constexpr size_t OFF_WINO  = OFF_FF2 + (size_t)2 * 4096 * 1024 * 2;
constexpr size_t OFF_WUQ   = OFF_WINO + (size_t)2304 * 1024 * 2;
constexpr size_t OFF_WUKV  = OFF_WUQ + (size_t)768 * 384 * 2;
constexpr size_t OFF_WOUTO = OFF_WUKV + (size_t)1024 * 256 * 2;
constexpr size_t OFF_WRA   = OFF_WOUTO + (size_t)1024 * 1024 * 2;
constexpr size_t OFF_WRX   = OFF_WRA + 262144;
constexpr size_t OFF_HMETA = OFF_WRX + 262144;
constexpr size_t OFF_GATES = OFF_HMETA + 524288;
constexpr size_t OFF_CTR   = OFF_GATES + (size_t)MP * 8 * 4;
constexpr size_t OFF_BAR   = OFF_CTR + 256;
constexpr size_t OFF_SS    = OFF_BAR + 14336;
constexpr size_t OFF_XN    = OFF_SS + (size_t)3 * MP * 4;
constexpr size_t OFF_Z     = OFF_XN + (size_t)MP * 1024 * 2;
constexpr int LDZE = 5120;
constexpr int LDZO = 2304;
constexpr size_t OFF_QRAW  = OFF_Z + (size_t)MP * LDZO * 2;
constexpr size_t OFF_KVRAW = OFF_QRAW + (size_t)MP * 768 * 2;
constexpr size_t OFF_KR    = OFF_KVRAW + (size_t)MP * 1024 * 2;
constexpr size_t OFF_ROPE  = OFF_KR + (size_t)MP * 32 * 2;
constexpr size_t OFF_FCUM  = OFF_ROPE + (size_t)MP * 32 * 4;
constexpr size_t OFF_YO    = OFF_FCUM + (size_t)64 * T * 4 + 256;
constexpr size_t OFF_SLAB  = (size_t)512 * 1024 * 1024 - (size_t)16 * 128 * 1024 * 4;

constexpr int HALF_LDS = 69632, SMEM_BYTES = 2 * HALF_LDS;

DEVI unsigned pk_bf16(float lo, float hi) { unsigned r; asm("v_cvt_pk_bf16_f32 %0, %1, %2" : "=v"(r) : "v"(lo), "v"(hi)); return r; }
DEVI float bf_lo(unsigned u) { return __uint_as_float(u << 16); }
DEVI float bf_hi(unsigned u) { return __uint_as_float(u & 0xffff0000u); }
DEVI float bf2f(bf16_t v) { return __uint_as_float(((unsigned)v) << 16); }
DEVI bf16_t f2bf(float f) { return (bf16_t)(pk_bf16(f, 0.f) & 0xffffu); }
DEVI int otid() { int t = threadIdx.x; asm volatile("" : "+v"(t)); return t; }
DEVI int obid() { int t = blockIdx.x; asm volatile("" : "+s"(t)); return t; }
DEVI float wave_sum(float v) { for (int o = 32; o; o >>= 1) v += __shfl_xor(v, o); return v; }
DEVI float sigmoidf_(float x) { return __builtin_amdgcn_rcpf(1.0f + __builtin_amdgcn_exp2f(-x * LOG2E)); }
DEVI float logsigmoidf_(float x) { return fminf(x, 0.f) - 0.6931471805599453f * __builtin_amdgcn_logf(1.0f + __builtin_amdgcn_exp2f(-fabsf(x) * LOG2E)); }
DEVI float neg_expm1_small(float x) { float q = 1.0f / 5040.0f; q = q * x + 1.0f / 720.0f; q = q * x + 1.0f / 120.0f; q = q * x + 1.0f / 24.0f; q = q * x + 1.0f / 6.0f; q = q * x + 0.5f; q = q * x + 1.0f; return -x * q; }
DEVI float* hrow(const Params& p, int r) {
  const int b = r / T, t = r - b * T;
  return t < 16 ? (float*)(p.ws + OFF_HMETA) + (size_t)(b * 16 + t) * 1024 : p.out + ((size_t)b * 4096 + (t - 16)) * 1024;
}
DEVI const float* xrow(const Params& p, int r) { const int b = r / T, t = r - b * T; return t < 16 ? p.meta + (size_t)t * 1024 : p.x + ((size_t)b * 4096 + (t - 16)) * 1024; }
DEVI bf16x8 mk8(uint2 a, uint2 b) { union { uint4 u; bf16x8 v; } c; c.u = make_uint4(a.x, a.y, b.x, b.y); return c.v; }
DEVI bf16x8 mk8u(uint4 a) { union { uint4 u; bf16x8 v; } c; c.u = a; return c.v; }
#define LBAR() do { asm volatile("s_waitcnt lgkmcnt(0)" ::: "memory"); __builtin_amdgcn_s_barrier(); asm volatile("" ::: "memory"); } while (0)
#define HBAR() do { asm volatile("s_waitcnt lgkmcnt(0)" ::: "memory"); hgen += 4u; \
    if (lane == 0) { (void)__hip_atomic_fetch_add(hcnt, 1u, __ATOMIC_RELAXED, __HIP_MEMORY_SCOPE_WORKGROUP); \
      while (__hip_atomic_load(hcnt, __ATOMIC_RELAXED, __HIP_MEMORY_SCOPE_WORKGROUP) < hgen) __builtin_amdgcn_s_sleep(1); } \
    asm volatile("" ::: "memory"); } while (0)
#define MFMA(a, b, c) __builtin_amdgcn_mfma_f32_16x16x32_bf16((a), (b), (c), 0, 0, 0)


namespace pg8 {
template <int ACT> struct EpiZ {
    static constexpr bool PERM = true, AFTER_DRAIN = false;
    bf16_t* O; int ldo; int gate0; float* gates; const float* ss;
    __device__ __forceinline__ void operator()(const f32x4 (&acc)[2][2][4][2], const Unit& u, int wr, int wc, int fr, int fq) const {
        const int row0 = u.pm * BM + wr * 64 + fr, col0 = u.pn * BM + wc * 32 + 8 * fq;
#pragma unroll
        for (int ai = 0; ai < 2; ++ai)
#pragma unroll
            for (int m = 0; m < 4; ++m) { const int row = row0 + ai * HALF + m * 16;
                const float rsc = ss ? rsqrtf(ss[row] * (1.0f / 1024.0f) + EPS) : 1.0f;
#pragma unroll
                for (int bj = 0; bj < 2; ++bj) { const int col = col0 + bj * HALF; f32x4 v0 = acc[ai][bj][m][0] * rsc, v1 = acc[ai][bj][m][1] * rsc;
                    if (ACT == 1) {
#pragma unroll
                        for (int j = 0; j < 4; ++j) { const float a = fmaxf(v0[j], 0.f), b = fmaxf(v1[j], 0.f); v0[j] = a * a; v1[j] = b * b; } }
                    if (col < gate0) { u32x4 w; w.x = pk_bf16(v0[0], v0[1]); w.y = pk_bf16(v0[2], v0[3]); w.z = pk_bf16(v1[0], v1[1]); w.w = pk_bf16(v1[2], v1[3]); *(u32x4*)(O + (size_t)row * ldo + col) = w; }
                    else if (col < gate0 + 8) { float* gp = gates + (size_t)row * 8; *(f32x4*)gp = v0; *(f32x4*)(gp + 4) = v1; } } }
    }
};
template <bool FIRST> struct EpiRes {
    static constexpr bool PERM = false, AFTER_DRAIN = false;
    const Params* p; float* ss; bf16_t* hb;
    __device__ __forceinline__ void operator()(const f32x4 (&acc)[2][2][4][2], const Unit& u, int wr, int wc, int fr, int fq) const {
        const int row0 = u.pm * BM + wr * 64 + fr, col0 = u.pn * BM + wc * 32 + 4 * fq;
#pragma unroll
        for (int ai = 0; ai < 2; ++ai)
#pragma unroll
            for (int m = 0; m < 4; ++m) { const int row = row0 + ai * HALF + m * 16;
                float sq = 0.f;
                if (row < M) { float* hp = hrow(*p, row) + col0; const float* sp = FIRST ? xrow(*p, row) + col0 : hp;
#pragma unroll
                    for (int bj = 0; bj < 2; ++bj)
#pragma unroll
                        for (int n = 0; n < 2; ++n) { f32x4 h = *(const f32x4*)(sp + bj * HALF + n * 16); h += acc[ai][bj][m][n]; *(f32x4*)(hp + bj * HALF + n * 16) = h;
                            if (ss) { sq += (h[0] * h[0] + h[1] * h[1]) + (h[2] * h[2] + h[3] * h[3]);
                                uint2 w; w.x = pk_bf16(h[0], h[1]); w.y = pk_bf16(h[2], h[3]); *(uint2*)(hb + (size_t)row * 1024 + col0 + bj * HALF + n * 16) = w; } } }
                if (ss) { sq += __shfl_xor(sq, 16); sq += __shfl_xor(sq, 32);
                    if (fq == 0 && row < M) (void)__hip_atomic_fetch_add(ss + row, sq, __ATOMIC_RELAXED, __HIP_MEMORY_SCOPE_AGENT); } }
    }
};

struct EpiSlab {
    static constexpr bool PERM = false, AFTER_DRAIN = false;
    float* slab; int ks;
    __device__ __forceinline__ void operator()(const f32x4 (&acc)[2][2][4][2], const Unit& u, int wr, int wc, int fr, int fq) const {
        const int col0 = u.pn * BM + wc * 32 + 4 * fq;
#pragma unroll
        for (int m = 0; m < 4; ++m) { float* sp = slab + ((size_t)(ks * 128 + wr * 64 + m * 16 + fr)) * 1024 + col0;
#pragma unroll
            for (int bj = 0; bj < 2; ++bj)
#pragma unroll
                for (int n = 0; n < 2; ++n) *(f32x4*)(sp + bj * HALF + n * 16) = acc[0][bj][m][n]; }
    }
};
struct TailOrder {
    int c, n, pm;
    __device__ __forceinline__ bool next(int i, Unit& u) const { if (i != 0 || c >= n) return false; u.pm = pm; u.pn = c & 3; return true; }
    __device__ __forceinline__ void a_ready(const Unit&) const {}
    __device__ __forceinline__ void done(const Unit&) const {}
};
template <class Epi, class Sched, bool ALIGN_EPI = false, bool SP2 = false>
__device__ __forceinline__ void gemm_phase(PG8_LAS unsigned char* lds, const Gemm g, const Sched& S, const Epi& E) {
    const int tid = otid(), wid = __builtin_amdgcn_readfirstlane(tid >> 6), lane = tid & 63, wr = wid >> 2, wc = wid & 3, fr = lane & 15, fq = lane >> 4;
    const int K = g.K, nt = K / BK;
    unsigned voffA[2], voffB[2];
#pragma unroll
    for (int i = 0; i < 2; ++i) { int R, C; stage_rc(tid * 16 + i * 8192, R, C); const int Rb = Epi::PERM ? ((R & ~31) + perm32(R & 31)) : R;
        voffA[i] = (unsigned)(R * g.lda + C) * 2u; voffB[i] = (unsigned)(Rb * g.ldb + C) * 2u; }
    const size_t kstep = (size_t)(BK * 2);
    const size_t hstepA = (size_t)HALF * g.lda * 2, hstepB = (size_t)HALF * g.ldb * 2;
    const size_t tstepA = 2 * hstepA, tstepB = 2 * hstepB;
    const unsigned ldsw = (unsigned)wid * 1024u;
    const int aoff = lds_byte(wr * 64 + fr, fq * 8), boff = lds_byte(wc * 32 + fr, fq * 8);
#define PG8_SA(b, h) (((b) * 2 + (h)) * HTB)
#define PG8_SB(b, h) ((4 + (b) * 2 + (h)) * HTB)
#define PG8_STAGE(bufoff, gbase, voff) do { _Pragma("unroll") for (int _i = 0; _i < 2; ++_i) \
        __builtin_amdgcn_global_load_lds((const unsigned*)((const char*)(gbase) + (voff)[_i]), (PG8_LAS unsigned*)(lds + (bufoff) + ldsw + _i * 8192), 16, 0, 0); } while (0)
#define PG8_LDA(dst, b, h) do { _Pragma("unroll") for (int m = 0; m < 4; ++m) _Pragma("unroll") for (int k = 0; k < 2; ++k) dst[m][k] = *(const PG8_LAS bf16x8*)(lds + PG8_SA(b, h) + aoff + m * 2048 + k * 1024); } while (0)
#define PG8_LDB(dst, b, h) do { _Pragma("unroll") for (int n = 0; n < 2; ++n) _Pragma("unroll") for (int k = 0; k < 2; ++k) dst[n][k] = *(const PG8_LAS bf16x8*)(lds + PG8_SB(b, h) + boff + n * 2048 + k * 1024); } while (0)
#define PG8_MMA(ai, bj, At, Bt) do { __builtin_amdgcn_s_setprio(1); _Pragma("unroll") for (int m = 0; m < 4; ++m) _Pragma("unroll") for (int n = 0; n < 2; ++n) _Pragma("unroll") for (int k = 0; k < 2; ++k) \
        acc[ai][bj][m][n] = __builtin_amdgcn_mfma_f32_16x16x32_bf16(Bt[n][k], At[m][k], acc[ai][bj][m][n], 0, 0, 0); __builtin_amdgcn_s_setprio(0); } while (0)
#define PG8_WAIT_V(n) asm volatile("s_waitcnt vmcnt(" #n ")" ::: "memory")
#define PG8_WAIT_L(n) asm volatile("s_waitcnt lgkmcnt(" #n ")" ::: "memory")
#define PG8_BAR __builtin_amdgcn_s_barrier()
#define PG8_SCHED __builtin_amdgcn_sched_barrier(0)
    Unit cur, nxt; int ui = 0;
    if (!S.next(0, cur)) return;
    f32x4 acc[2][2][4][2];
#pragma unroll
    for (int a = 0; a < 2; ++a)
#pragma unroll
        for (int b = 0; b < 2; ++b)
#pragma unroll
            for (int m = 0; m < 4; ++m)
#pragma unroll
                for (int n = 0; n < 2; ++n) acc[a][b][m][n] = (f32x4){0.f, 0.f, 0.f, 0.f};
    bf16x8 At[4][2], B0[2][2], B1[2][2];
    const char* cA = (const char*)g.A + (size_t)cur.pm * tstepA; const char* cB = (const char*)g.Bt + (size_t)cur.pn * tstepB;
    S.a_ready(cur);
    if constexpr (SP2) {
        PG8_STAGE(PG8_SB(0, 0), cB, voffB); PG8_STAGE(PG8_SB(0, 1), cB + hstepB, voffB); PG8_STAGE(PG8_SA(0, 0), cA, voffA); PG8_STAGE(PG8_SA(0, 1), cA + hstepA, voffA);
        if (wr == 1) PG8_BAR;
        PG8_WAIT_V(2); PG8_BAR;
        PG8_STAGE(PG8_SB(1, 0), cB + kstep, voffB); PG8_STAGE(PG8_SA(1, 0), cA + kstep, voffA); PG8_STAGE(PG8_SB(1, 1), cB + hstepB + kstep, voffB);
        PG8_WAIT_V(6); PG8_BAR;
    } else {
        PG8_STAGE(PG8_SB(0, 0), cB, voffB); PG8_STAGE(PG8_SA(0, 0), cA, voffA); PG8_STAGE(PG8_SB(0, 1), cB + hstepB, voffB); PG8_STAGE(PG8_SA(0, 1), cA + hstepA, voffA);
        if (wr == 1) PG8_BAR;
        PG8_WAIT_V(4); PG8_BAR;
        PG8_STAGE(PG8_SB(1, 0), cB + kstep, voffB); PG8_STAGE(PG8_SA(1, 0), cA + kstep, voffA); PG8_STAGE(PG8_SB(1, 1), cB + hstepB + kstep, voffB);
        PG8_WAIT_V(6); PG8_BAR;
    }
    for (;;) {
        const bool has_next = S.next(ui + 1, nxt);
        const char* nA = has_next ? (const char*)g.A + (size_t)nxt.pm * tstepA : cA; const char* nB = has_next ? (const char*)g.Bt + (size_t)nxt.pn * tstepB : cB;
        for (int t = 0; t < nt; t += 2) {
            const bool last = (t == nt - 2);
            const char* a1 = cA + (size_t)(t + 1) * kstep;
            const char* a2 = last ? nA : cA + (size_t)(t + 2) * kstep; const char* b2 = last ? nB : cB + (size_t)(t + 2) * kstep;
            const char* a3 = a2 + kstep; const char* b3 = b2 + kstep;
            if (last && has_next) S.a_ready(nxt);
            if constexpr (SP2) {
            PG8_LDB(B0, 0, 0); PG8_LDB(B1, 0, 1); PG8_SCHED; PG8_LDA(At, 0, 0); PG8_STAGE(PG8_SA(1, 1), a1 + hstepA, voffA);
            PG8_WAIT_V(8); PG8_WAIT_L(0); PG8_BAR; PG8_MMA(0, 0, At, B0); PG8_MMA(0, 1, At, B1); PG8_BAR; PG8_SCHED;
            PG8_LDA(At, 0, 1); PG8_STAGE(PG8_SB(0, 0), b2, voffB); PG8_STAGE(PG8_SB(0, 1), b2 + hstepB, voffB); PG8_STAGE(PG8_SA(0, 0), a2, voffA);
            PG8_WAIT_V(8); PG8_WAIT_L(0); PG8_BAR; PG8_MMA(1, 0, At, B0); PG8_MMA(1, 1, At, B1); PG8_BAR; PG8_SCHED;
            PG8_LDB(B0, 1, 0); PG8_LDB(B1, 1, 1); PG8_SCHED; PG8_LDA(At, 1, 0); PG8_STAGE(PG8_SA(0, 1), a2 + hstepA, voffA);
            PG8_WAIT_V(8); PG8_WAIT_L(0); PG8_BAR; PG8_MMA(0, 0, At, B0); PG8_MMA(0, 1, At, B1); PG8_BAR; PG8_SCHED;
            PG8_LDA(At, 1, 1); PG8_STAGE(PG8_SB(1, 0), b3, voffB); PG8_STAGE(PG8_SB(1, 1), b3 + hstepB, voffB); PG8_STAGE(PG8_SA(1, 0), a3, voffA);
            PG8_WAIT_V(8); PG8_WAIT_L(0); PG8_BAR; PG8_MMA(1, 0, At, B0); PG8_MMA(1, 1, At, B1); PG8_BAR; PG8_SCHED;
            } else {
            PG8_LDB(B0, 0, 0); PG8_SCHED; PG8_LDA(At, 0, 0); PG8_STAGE(PG8_SA(1, 1), a1 + hstepA, voffA);
            PG8_WAIT_L(8); PG8_BAR; PG8_WAIT_L(0); PG8_MMA(0, 0, At, B0); PG8_BAR; PG8_SCHED;
            PG8_LDB(B1, 0, 1); PG8_STAGE(PG8_SB(0, 0), b2, voffB);
            PG8_BAR; PG8_WAIT_L(0); PG8_MMA(0, 1, At, B1); PG8_BAR;
            PG8_LDA(At, 0, 1); PG8_STAGE(PG8_SA(0, 0), a2, voffA);
            PG8_BAR; PG8_WAIT_L(0); PG8_MMA(1, 0, At, B0); PG8_BAR; PG8_SCHED;
            PG8_STAGE(PG8_SB(0, 1), b2 + hstepB, voffB);
            PG8_WAIT_V(6); PG8_BAR; PG8_MMA(1, 1, At, B1); PG8_BAR;
            PG8_LDB(B0, 1, 0); PG8_SCHED; PG8_LDA(At, 1, 0); PG8_STAGE(PG8_SA(0, 1), a2 + hstepA, voffA);
            PG8_WAIT_L(8); PG8_BAR; PG8_WAIT_L(0); PG8_MMA(0, 0, At, B0); PG8_BAR; PG8_SCHED;
            PG8_LDB(B1, 1, 1); PG8_STAGE(PG8_SB(1, 0), b3, voffB);
            PG8_BAR; PG8_WAIT_L(0); PG8_MMA(0, 1, At, B1); PG8_BAR;
            PG8_LDA(At, 1, 1); PG8_STAGE(PG8_SA(1, 0), a3, voffA);
            PG8_BAR; PG8_WAIT_L(0); PG8_MMA(1, 0, At, B0); PG8_BAR; PG8_SCHED;
            PG8_STAGE(PG8_SB(1, 1), b3 + hstepB, voffB);
            PG8_WAIT_V(6); PG8_BAR; PG8_MMA(1, 1, At, B1); PG8_BAR;
            }
        }
        if constexpr (ALIGN_EPI) { if (wr == 0) PG8_BAR; }
        if constexpr (!Epi::AFTER_DRAIN) { E(acc, cur, wr, wc, fr, fq); S.done(cur); }
        if (!has_next) break;
#pragma unroll
        for (int a = 0; a < 2; ++a)
#pragma unroll
            for (int b = 0; b < 2; ++b)
#pragma unroll
                for (int m = 0; m < 4; ++m)
#pragma unroll
                    for (int n = 0; n < 2; ++n) acc[a][b][m][n] = (f32x4){0.f, 0.f, 0.f, 0.f};
        cur = nxt; cA = nA; cB = nB; ++ui;
        if constexpr (ALIGN_EPI) { if (wr == 1) PG8_BAR; }
    }
    PG8_WAIT_V(0);
    if constexpr (!ALIGN_EPI) { if (wr == 0) PG8_BAR; }
    PG8_BAR;
    if constexpr (Epi::AFTER_DRAIN) { E.fused(acc, cur, wr, wc, fr, fq, lds, wid, lane); S.done(cur); }
#undef PG8_SA
#undef PG8_SB
#undef PG8_STAGE
#undef PG8_LDA
#undef PG8_LDB
#undef PG8_MMA
#undef PG8_WAIT_V
#undef PG8_WAIT_L
#undef PG8_BAR
#undef PG8_SCHED
}
}
__device__ __forceinline__ void wconv(unsigned char* lds, const float* __restrict__ src, bf16_t* __restrict__ dst, int K, int Nsrc, int Ndst, int mode, int nbatch, const float* __restrict__ rg = nullptr) {
  float* tile = (float*)lds;
  const int tid = otid();
  const int tk = K >> 6, tn = Ndst >> 6, per = tk * tn, total = per * nbatch;
  for (int it = obid(); it < total; it += gridDim.x) {
    const int bi = it / per, rem = it - bi * per, kt = rem / tn, nt = rem - kt * tn;
    const float* s = src + (size_t)bi * K * Nsrc; bf16_t* d = dst + (size_t)bi * Ndst * K;
    const int nn = tid & 63, dcol = nt * 64 + nn;
    int scol; float scale = 1.f;
    if (mode == 0) scol = dcol < Nsrc ? dcol : -1;
    else {
      if (dcol < 2048) { scol = dcol; if (dcol >= 512 && dcol < 1024) scale = 0.08838834764831845f; }
      else if (dcol < 3072) scol = dcol - 2048 + 3080;
      else if (dcol < 4096) scol = dcol - 3072 + 2048;
      else if (dcol < 5120) scol = dcol - 4096 + 4104;
      else if (dcol < 5128) scol = dcol - 5120 + 3072;
      else scol = -1;
    }
    __syncthreads();
#pragma unroll
    for (int i = 0; i < 8; ++i) {
      const int kk = (tid >> 6) + 8 * i;
      float v = 0.f; if (scol >= 0) { v = s[(size_t)(kt * 64 + kk) * Nsrc + scol] * scale; if (rg) v *= rg[(size_t)bi * K + kt * 64 + kk]; }
      tile[kk * 65 + nn] = v;
    }
    __syncthreads();
    {
      const int q = tid, n2 = q >> 3, kc = q & 7;
      float v[8];
#pragma unroll
      for (int j = 0; j < 8; ++j) v[j] = tile[(kc * 8 + j) * 65 + n2];
      uint4 w = make_uint4(pk_bf16(v[0], v[1]), pk_bf16(v[2], v[3]), pk_bf16(v[4], v[5]), pk_bf16(v[6], v[7]));
      *(uint4*)(d + (size_t)(nt * 64 + n2) * K + kt * 64 + kc * 8) = w;
    }
  }
  __syncthreads();
}

__device__ __forceinline__ void norm_phase(const Params& p, const float* __restrict__ gain, int mode, int nslab) {
  const int tid = otid(); const int lane = tid & 63, wave = (obid() * NT + tid) >> 6, nw = gridDim.x * (NT / 64);
  bf16_t* xn = (bf16_t*)(p.ws + OFF_XN);
  auto srcrow = [&](int r) -> const float* {
    if (mode == 1 || (mode == 2 && r >= 32768)) return xrow(p, r);
    return hrow(p, r); };
  float4 v[4], vn[4];
  if (wave < M) { const float* src = srcrow(wave);
#pragma unroll
    for (int i = 0; i < 4; ++i) vn[i] = *(const float4*)(src + i * 256 + lane * 4); }
  for (int r = wave; r < M; r += nw) {
    float* hp = hrow(p, r);
#pragma unroll
    for (int i = 0; i < 4; ++i) v[i] = vn[i];
    if (r + nw < M) { const float* src = srcrow(r + nw);
#pragma unroll
      for (int i = 0; i < 4; ++i) vn[i] = *(const float4*)(src + i * 256 + lane * 4); }
    if (nslab > 0 && r >= 32768) {
      const float* sl = (const float*)(p.ws + OFF_SLAB) + (size_t)(r - 32768) * 1024 + lane * 4;
      for (int sI = 0; sI < nslab; ++sI)
#pragma unroll
        for (int i = 0; i < 4; ++i) { const float4 a = *(const float4*)(sl + (size_t)sI * 131072 + i * 256); v[i].x += a.x; v[i].y += a.y; v[i].z += a.z; v[i].w += a.w; }
#pragma unroll
      for (int i = 0; i < 4; ++i) *(float4*)(hp + i * 256 + lane * 4) = v[i];
    }
    float ss = 0.f;
#pragma unroll
    for (int i = 0; i < 4; ++i) ss += v[i].x * v[i].x + v[i].y * v[i].y + v[i].z * v[i].z + v[i].w * v[i].w;
    ss = wave_sum(ss);
    const float rs = rsqrtf(ss * (1.0f / 1024.0f) + EPS);
#pragma unroll
    for (int i = 0; i < 4; ++i) {
      const float4 g = *(const float4*)(gain + i * 256 + lane * 4);
      uint2 w; w.x = pk_bf16(v[i].x * rs * g.x, v[i].y * rs * g.y); w.y = pk_bf16(v[i].z * rs * g.z, v[i].w * rs * g.w);
      *(uint2*)(xn + (size_t)r * 1024 + i * 256 + lane * 4) = w;
    }
  }
}

__device__ __forceinline__ void mlstm_item(const Params& p, unsigned char* lds, int item, const int tid, unsigned* hcnt, unsigned& hgen) {
  const int w = tid >> 6, lane = tid & 63, fr = lane & 15, fq = lane >> 4;
  const int sl = item & 7, hh = (item >> 3) & 3, b = item >> 5;
  bf16_t* Z = (bf16_t*)(p.ws + OFF_Z);
  const float* GE = (const float*)(p.ws + OFF_GATES);
  bf16_t* Qs = (bf16_t*)lds;
  bf16_t* Ks = Qs + 64 * 136;
  bf16_t* Kt = Ks + 64 * 136;
  bf16_t* Vt = Kt + 128 * 72;
  bf16_t* Ct = Vt + 32 * 72;
  float* fv = (float*)(Ct + 32 * 136);
  float *rowt = fv, *cols = fv + 64, *winter = fv + 128, *emr = fv + 192, *wkv = fv + 256, *denv = fv + 320, *qn = fv + 384, *nv = fv + 448, *scal = fv + 576;
  const float bI = p.ev_b_if[hh], bF = p.ev_b_if[4 + hh];
  f32x4 Cacc[2][2];
#pragma unroll
  for (int i = 0; i < 2; ++i)
#pragma unroll
    for (int j = 0; j < 2; ++j) Cacc[i][j] = (f32x4){0.f, 0.f, 0.f, 0.f};
  float m_state = 0.f;
  HBAR();
  if (tid < 128) nv[tid] = 0.f;
  uint4 rqA[4], rkA[4], rvA, rqB[4], rkB[4], rvB; float giA = 0.f, gfA = 0.f, giB = 0.f, gfB = 0.f;
  auto prefetch = [&](int c, uint4 (&rq)[4], uint4 (&rk)[4], uint4& rv, float& gi, float& gf) {
#pragma unroll
    for (int i = 0; i < 4; ++i) {
      const int tok = 64 * c - 48 + lane;
      if (tok >= 0) { const bf16_t* s = Z + (size_t)(b * T + tok) * LDZE + hh * 128 + (4 * w + i) * 8; rq[i] = *(const uint4*)s; rk[i] = *(const uint4*)(s + 512); }
      else { rq[i] = make_uint4(0, 0, 0, 0); rk[i] = make_uint4(0, 0, 0, 0); }
    }
    { const int tok = 64 * c - 48 + lane;
      if (tok >= 0) rv = *(const uint4*)(Z + (size_t)(b * T + tok) * LDZE + 1024 + hh * 256 + sl * 32 + w * 8); else rv = make_uint4(0, 0, 0, 0); }
    if (w == 0) { const int tok = 64 * c - 48 + lane; if (tok >= 0) { gi = GE[(size_t)(b * T + tok) * 8 + hh]; gf = GE[(size_t)(b * T + tok) * 8 + 4 + hh]; } }
  };
  prefetch(0, rqA, rkA, rvA, giA, gfA); prefetch(1, rqB, rkB, rvB, giB, gfB);
  auto chunk_step = [&](const int c, uint4 (&rq)[4], uint4 (&rk)[4], uint4& rv, float& gi, float& gf) {
    if (w == 0) {
      const bool valid = (c > 0) || (lane >= 48);
      const float lf = valid ? logsigmoidf_(gf + bF) : 0.f;
      const float li = valid ? gi + bI : -INFINITY;
      float bb = lf;
#pragma unroll
      for (int o = 1; o < 64; o <<= 1) { const float t = __shfl_up(bb, o); if (lane >= o) bb += t; }
      const float g = __shfl(bb, 63);
      const float cs = li - bb;
      float pm = cs;
#pragma unroll
      for (int o = 1; o < 64; o <<= 1) { const float t = __shfl_up(pm, o); if (lane >= o) pm = fmaxf(pm, t); }
      const float pmax = __shfl(pm, 63);
      const float inter = bb + m_state, mrow = fmaxf(inter, bb + pm);
      rowt[lane] = bb - mrow; cols[lane] = cs; winter[lane] = __expf(inter - mrow); emr[lane] = __expf(-mrow);
      const float m_new = fmaxf(g + m_state, g + pmax);
      wkv[lane] = __expf(g + cs - m_new);
      if (lane == 0) scal[0] = __expf(g + m_state - m_new);
      m_state = m_new;
    }
#pragma unroll
    for (int i = 0; i < 4; ++i) { *(uint4*)(Qs + lane * 136 + (4 * w + i) * 8) = rq[i]; *(uint4*)(Ks + lane * 136 + (4 * w + i) * 8) = rk[i]; }
    { const unsigned vv[4] = {rv.x, rv.y, rv.z, rv.w};
#pragma unroll
      for (int j = 0; j < 4; ++j) { Vt[(w * 8 + 2 * j) * 72 + lane] = (bf16_t)(vv[j] & 0xffffu); Vt[(w * 8 + 2 * j + 1) * 72 + lane] = (bf16_t)(vv[j] >> 16); } }
#pragma unroll
    for (int dt = 0; dt < 2; ++dt)
#pragma unroll
      for (int et = 0; et < 2; ++et) { uint2 wv; wv.x = pk_bf16(Cacc[dt][et][0], Cacc[dt][et][1]); wv.y = pk_bf16(Cacc[dt][et][2], Cacc[dt][et][3]);
        *(uint2*)(Ct + (16 * et + fr) * 136 + 16 * (2 * w + dt) + 4 * fq) = wv; }
    HBAR();
#pragma unroll
    for (int i = 0; i < 4; ++i) {
      const float wks = wkv[lane];
      const unsigned kk[4] = {rk[i].x, rk[i].y, rk[i].z, rk[i].w};
#pragma unroll
      for (int j = 0; j < 4; ++j) { const unsigned pr = pk_bf16(bf_lo(kk[j]) * wks, bf_hi(kk[j]) * wks);
        Kt[((4 * w + i) * 8 + 2 * j) * 72 + lane] = (bf16_t)(pr & 0xffffu); Kt[((4 * w + i) * 8 + 2 * j + 1) * 72 + lane] = (bf16_t)(pr >> 16); }
    }
    if (c + 2 < 65) prefetch(c + 2, rq, rk, rv, gi, gf);
    f32x4 S[4];
#pragma unroll
    for (int st = 0; st < 4; ++st) S[st] = (f32x4){0.f, 0.f, 0.f, 0.f};
#pragma unroll
    for (int ks = 0; ks < 4; ++ks) {
      const bf16x8 bq = *(const bf16x8*)(Qs + (16 * w + fr) * 136 + 32 * ks + 8 * fq);
#pragma unroll
      for (int st = 0; st < 4; ++st) if (st <= w) { const bf16x8 ak = *(const bf16x8*)(Ks + (16 * st + fr) * 136 + 32 * ks + 8 * fq); S[st] = MFMA(ak, bq, S[st]); }
    }
    const float rt = rowt[16 * w + fr];
    float dsum = 0.f;
#pragma unroll
    for (int st = 0; st < 4; ++st)
#pragma unroll
      for (int r = 0; r < 4; ++r) {
        const int s = 16 * st + 4 * fq + r, t = 16 * w + fr;
        float v = 0.f; if (st <= w && s <= t) v = S[st][r] * __expf(rt + cols[s]);
        S[st][r] = v; dsum += v;
      }
    dsum += __shfl_xor(dsum, 16); dsum += __shfl_xor(dsum, 32);
    if (fq == 0) denv[16 * w + fr] = dsum;
    bf16x8 pa[2];
#pragma unroll
    for (int k2 = 0; k2 < 2; ++k2) { uint2 lo, hi; lo.x = pk_bf16(S[2 * k2][0], S[2 * k2][1]); lo.y = pk_bf16(S[2 * k2][2], S[2 * k2][3]);
      hi.x = pk_bf16(S[2 * k2 + 1][0], S[2 * k2 + 1][1]); hi.y = pk_bf16(S[2 * k2 + 1][2], S[2 * k2 + 1][3]); pa[k2] = mk8(lo, hi); }
    {
      const int t = tid >> 2, part = tid & 3; float s = 0.f;
#pragma unroll
      for (int j = 0; j < 4; ++j) { const uint4 qv = *(const uint4*)(Qs + t * 136 + part * 32 + j * 8); const float* np = nv + part * 32 + j * 8;
        s += bf_lo(qv.x) * np[0] + bf_hi(qv.x) * np[1] + bf_lo(qv.y) * np[2] + bf_hi(qv.y) * np[3] + bf_lo(qv.z) * np[4] + bf_hi(qv.z) * np[5] + bf_lo(qv.w) * np[6] + bf_hi(qv.w) * np[7]; }
      s += __shfl_xor(s, 1); s += __shfl_xor(s, 2);
      if (part == 0) qn[t] = s;
    }
    HBAR();
    f32x4 intra[2], inter[2];
#pragma unroll
    for (int et = 0; et < 2; ++et) { intra[et] = (f32x4){0.f, 0.f, 0.f, 0.f}; inter[et] = (f32x4){0.f, 0.f, 0.f, 0.f}; }
#pragma unroll
    for (int k2 = 0; k2 < 2; ++k2) if (2 * k2 <= w) {
#pragma unroll
      for (int et = 0; et < 2; ++et) {
        const uint2 v0 = *(const uint2*)(Vt + (16 * et + fr) * 72 + 32 * k2 + 4 * fq), v1 = *(const uint2*)(Vt + (16 * et + fr) * 72 + 32 * k2 + 16 + 4 * fq);
        intra[et] = MFMA(pa[k2], mk8(v0, v1), intra[et]);
      }
    }
#pragma unroll
    for (int kd = 0; kd < 4; ++kd) {
      const bf16x8 aq = *(const bf16x8*)(Qs + (16 * w + fr) * 136 + 32 * kd + 8 * fq);
#pragma unroll
      for (int et = 0; et < 2; ++et) { const bf16x8 cb = *(const bf16x8*)(Ct + (16 * et + fr) * 136 + 32 * kd + 8 * fq); inter[et] = MFMA(aq, cb, inter[et]); }
    }
#pragma unroll
    for (int r = 0; r < 4; ++r) {
      const int tl = 16 * w + 4 * fq + r, tok = 64 * c - 48 + tl;
      const float wi = winter[tl], dn = wi * qn[tl] + denv[tl], dd = fmaxf(fabsf(dn), emr[tl]), inv = 1.0f / dd;
      if (tok >= 0) {
#pragma unroll
        for (int et = 0; et < 2; ++et) Z[(size_t)(b * T + tok) * LDZE + 1024 + hh * 256 + sl * 32 + 16 * et + fr] = f2bf((wi * inter[et][r] + intra[et][r]) * inv);
      }
    }
    const float sc = scal[0];
#pragma unroll
    for (int dt = 0; dt < 2; ++dt)
#pragma unroll
      for (int et = 0; et < 2; ++et) {
        f32x4 a = Cacc[dt][et] * sc;
#pragma unroll
        for (int ks = 0; ks < 2; ++ks) { const bf16x8 ak = *(const bf16x8*)(Kt + (16 * (2 * w + dt) + fr) * 72 + 32 * ks + 8 * fq); const bf16x8 vb = *(const bf16x8*)(Vt + (16 * et + fr) * 72 + 32 * ks + 8 * fq); a = MFMA(ak, vb, a); }
        Cacc[dt][et] = a;
      }
    if (tid < 128) { float s = 0.f;
#pragma unroll
      for (int j = 0; j < 8; ++j) { const uint4 kv = *(const uint4*)(Kt + tid * 72 + j * 8); s += bf_lo(kv.x) + bf_hi(kv.x) + bf_lo(kv.y) + bf_hi(kv.y) + bf_lo(kv.z) + bf_hi(kv.z) + bf_lo(kv.w) + bf_hi(kv.w); }
      nv[tid] = sc * nv[tid] + s; }
    HBAR();
  };
  for (int c = 0; c < 65; c += 2) {
    chunk_step(c, rqA, rkA, rvA, giA, gfA);
    if (c + 1 < 65) chunk_step(c + 1, rqB, rkB, rvB, giB, gfB);
  }
}

__device__ __forceinline__ void rglru_item(const Params& p, unsigned char* lds, int item, const int tid, unsigned* hcnt, unsigned& hgen) {
  const int w = tid >> 6, lane = tid & 63, fr = lane & 15, fq = lane >> 4;
  const int q4 = item & 3, g = (item >> 2) & 7, b = item >> 5;
  bf16_t* Z = (bf16_t*)(p.ws + OFF_Z);
  bf16_t* raw = (bf16_t*)lds;
  bf16_t* xcA = raw + 67 * 136;
  float* xcF = (float*)(xcA + 64 * 136);
  float* aS = xcF + 2112;
  float* uS = aS + 2112;
  float* cw = uS + 2112;
  float* segP = cw + 640;
  float* segL = segP + 256;
  float* hst = segL + 256;
  HBAR();
  for (int i = tid; i < 640; i += 256) { const int k = i >> 7, c = i & 127; cw[i] = k < 4 ? p.ev_conv_w[k * 1024 + g * 128 + c] : p.ev_conv_b[g * 128 + c]; }
  if (tid < 204) ((unsigned*)raw)[tid] = 0u;
  if (tid < 64) hst[tid] = 0.f;
  const bf16_t* WA = (const bf16_t*)(p.ws + OFF_WRA) + (size_t)g * 16384;
  const bf16_t* WX = (const bf16_t*)(p.ws + OFF_WRX) + (size_t)g * 16384;
  bf16x8 wa[2][4], wx[2][4]; float ba[2], bx[2], sp[2];
#pragma unroll
  for (int nt = 0; nt < 2; ++nt) {
    const int jc = q4 * 32 + 16 * nt + fr, cgi = g * 128 + jc;
#pragma unroll
    for (int kk = 0; kk < 4; ++kk) { wa[nt][kk] = *(const bf16x8*)(WA + jc * 128 + 32 * kk + 8 * fq); wx[nt][kk] = *(const bf16x8*)(WX + jc * 128 + 32 * kk + 8 * fq); }
    ba[nt] = p.ev_b_ra[cgi]; bx[nt] = p.ev_b_rx[cgi]; sp[nt] = log1pf(__expf(-p.ev_lam[cgi]));
  }
  const int prow = tid >> 4, pch = tid & 15;
  uint4 rx[4];
  auto prefetch = [&](int ti) {
#pragma unroll
    for (int i = 0; i < 4; ++i) { const int t = 64 * ti + prow + 16 * i;
      if (t < T) rx[i] = *(const uint4*)(Z + (size_t)(b * T + t) * LDZE + 2048 + g * 128 + pch * 8); else rx[i] = make_uint4(0, 0, 0, 0); }
  };
  prefetch(0);
  int cur = 0;
  for (int ti = 0; ti < 65; ++ti) {
    HBAR();
#pragma unroll
    for (int i = 0; i < 4; ++i) *(uint4*)(raw + (3 + prow + 16 * i) * 136 + pch * 8) = rx[i];
    HBAR();
    {
      const int tr = tid >> 2, cp = tid & 3;
#pragma unroll
      for (int c8 = 0; c8 < 4; ++c8) {
        const int c0 = cp * 32 + c8 * 8; float o[8];
#pragma unroll
        for (int j = 0; j < 8; ++j) o[j] = cw[512 + c0 + j];
#pragma unroll
        for (int k = 0; k < 4; ++k) { const uint4 xv = *(const uint4*)(raw + (tr + k) * 136 + c0); const float* wp = cw + k * 128 + c0;
          o[0] += wp[0] * bf_lo(xv.x); o[1] += wp[1] * bf_hi(xv.x); o[2] += wp[2] * bf_lo(xv.y); o[3] += wp[3] * bf_hi(xv.y);
          o[4] += wp[4] * bf_lo(xv.z); o[5] += wp[5] * bf_hi(xv.z); o[6] += wp[6] * bf_lo(xv.w); o[7] += wp[7] * bf_hi(xv.w); }
        *(uint4*)(xcA + tr * 136 + c0) = make_uint4(pk_bf16(o[0], o[1]), pk_bf16(o[2], o[3]), pk_bf16(o[4], o[5]), pk_bf16(o[6], o[7]));
        if (cp == q4) {
#pragma unroll
          for (int j = 0; j < 8; ++j) xcF[tr * 33 + c8 * 8 + j] = o[j]; }
      }
    }
    HBAR();
    if (tid < 192) ((unsigned*)raw)[(tid >> 6) * 68 + (tid & 63)] = ((unsigned*)raw)[(64 + (tid >> 6)) * 68 + (tid & 63)];
    if (ti + 1 < 65) prefetch(ti + 1);
    bf16_t gbv[8];
    { const int j = tid & 31, seg = tid >> 5;
#pragma unroll
      for (int k = 0; k < 8; ++k) { const int t = 64 * ti + 8 * seg + k; gbv[k] = t < T ? Z[(size_t)(b * T + t) * LDZE + 4096 + g * 128 + q4 * 32 + j] : (bf16_t)0; } }
    {
      f32x4 R[2], I[2];
#pragma unroll
      for (int nt = 0; nt < 2; ++nt) { R[nt] = (f32x4){0.f, 0.f, 0.f, 0.f}; I[nt] = (f32x4){0.f, 0.f, 0.f, 0.f}; }
#pragma unroll
      for (int kk = 0; kk < 4; ++kk) { const bf16x8 ax = *(const bf16x8*)(xcA + (16 * w + fr) * 136 + 32 * kk + 8 * fq);
#pragma unroll
        for (int nt = 0; nt < 2; ++nt) { R[nt] = MFMA(ax, wa[nt][kk], R[nt]); I[nt] = MFMA(ax, wx[nt][kk], I[nt]); } }
#pragma unroll
      for (int nt = 0; nt < 2; ++nt)
#pragma unroll
        for (int r = 0; r < 4; ++r) {
          const int t = 16 * w + 4 * fq + r, jl = 16 * nt + fr;
          const float rg = sigmoidf_(R[nt][r] + ba[nt]), ig = sigmoidf_(I[nt][r] + bx[nt]);
          const float la = -8.0f * rg * sp[nt];
          aS[t * 33 + jl] = __builtin_amdgcn_exp2f(la * LOG2E);
          const float x2 = 2.0f * la, om = x2 > -0.25f ? neg_expm1_small(x2) : 1.0f - __builtin_amdgcn_exp2f(x2 * LOG2E);
          uS[t * 33 + jl] = __builtin_amdgcn_sqrtf(om) * (ig * xcF[t * 33 + jl]);
        }
    }
    HBAR();
    const int j = tid & 31, seg = tid >> 5;
    float Lk[8], Pk[8];
    { float P = 1.f, L = 0.f;
#pragma unroll
      for (int k = 0; k < 8; ++k) { const float a = aS[(8 * seg + k) * 33 + j], u = uS[(8 * seg + k) * 33 + j]; L = a * L + u; P = a * P; Lk[k] = L; Pk[k] = P; }
      segP[seg * 32 + j] = P; segL[seg * 32 + j] = L; }
    HBAR();
    { float hin = hst[cur * 32 + j];
#pragma unroll
      for (int s = 0; s < 7; ++s) if (s < seg) hin = segP[s * 32 + j] * hin + segL[s * 32 + j];
#pragma unroll
      for (int k = 0; k < 8; ++k) {
        const float hv = Lk[k] + Pk[k] * hin; const int t = 64 * ti + 8 * seg + k;
        if (k == 7 && seg == 7) hst[(cur ^ 1) * 32 + j] = hv;
        if (t < T) { bf16_t* gp = Z + (size_t)(b * T + t) * LDZE + 4096 + g * 128 + q4 * 32 + j; const float x = bf2f(gbv[k]);
          const float ge = x * sigmoidf_(1.5957691216057308f * (x + 0.044715f * x * x * x)); *gp = f2bf(hv * ge); }
      }
    }
    cur ^= 1;
  }
}

__device__ __forceinline__ void anorm_phase(const Params& p) {
  const int tid = otid(); const int lane = tid & 63, wave = (obid() * NT + tid) >> 6, nw = gridDim.x * (NT / 64);
  bf16_t* Z = (bf16_t*)(p.ws + OFF_Z);
  for (int r = wave; r < M; r += nw) {
    bf16_t* zr = Z + (size_t)r * LDZE;
    const uint4 h0 = *(const uint4*)(zr + 1024 + 16 * lane), h1 = *(const uint4*)(zr + 1024 + 16 * lane + 8);
    const uint4 o0 = *(const uint4*)(zr + 3072 + 16 * lane), o1 = *(const uint4*)(zr + 3072 + 16 * lane + 8);
    const unsigned hu[8] = {h0.x, h0.y, h0.z, h0.w, h1.x, h1.y, h1.z, h1.w}, ou[8] = {o0.x, o0.y, o0.z, o0.w, o1.x, o1.y, o1.z, o1.w};
    float hv[16], ov[16]; float ss = 0.f;
#pragma unroll
    for (int i = 0; i < 8; ++i) { hv[2 * i] = bf_lo(hu[i]); hv[2 * i + 1] = bf_hi(hu[i]); ov[2 * i] = bf_lo(ou[i]); ov[2 * i + 1] = bf_hi(ou[i]); ss += hv[2 * i] * hv[2 * i] + hv[2 * i + 1] * hv[2 * i + 1]; }
    ss += __shfl_xor(ss, 1); ss += __shfl_xor(ss, 2); ss += __shfl_xor(ss, 4); ss += __shfl_xor(ss, 8);
    const float rs = rsqrtf(ss * (1.0f / 256.0f) + EPS);
    const float* gp = p.ev_a_norm + ((16 * lane) & 255);
    unsigned res[8];
#pragma unroll
    for (int i = 0; i < 8; ++i) res[i] = pk_bf16(hv[2 * i] * rs * gp[2 * i] * sigmoidf_(ov[2 * i]), hv[2 * i + 1] * rs * gp[2 * i + 1] * sigmoidf_(ov[2 * i + 1]));
    *(uint4*)(zr + 3072 + 16 * lane) = make_uint4(res[0], res[1], res[2], res[3]);
    *(uint4*)(zr + 3072 + 16 * lane + 8) = make_uint4(res[4], res[5], res[6], res[7]);
  }
}

__device__ __forceinline__ void oddprep_phase(const Params& p) {
  const int tid = otid(); const int lane = tid & 63, wave = (obid() * NT + tid) >> 6, nw = gridDim.x * (NT / 64);
  bf16_t* Zo = (bf16_t*)(p.ws + OFF_Z);
  float* G = (float*)(p.ws + OFF_GATES);
  bf16_t* KR = (bf16_t*)(p.ws + OFF_KR);
  float* ROPE = (float*)(p.ws + OFF_ROPE);
  for (int r = wave; r < M; r += nw) {
    bf16_t* zr = Zo + (size_t)r * LDZO;
    {
      unsigned u[3]; float ss = 0.f;
#pragma unroll
      for (int j = 0; j < 3; ++j) { u[j] = *(const unsigned*)(zr + 128 * j + 2 * lane); ss += bf_lo(u[j]) * bf_lo(u[j]) + bf_hi(u[j]) * bf_hi(u[j]); }
      ss = wave_sum(ss); const float rs = rsqrtf(ss * (1.0f / 384.0f) + EPS);
#pragma unroll
      for (int j = 0; j < 3; ++j) { const float* gp = p.od_g_qa + 128 * j + 2 * lane; *(unsigned*)(zr + 128 * j + 2 * lane) = pk_bf16(bf_lo(u[j]) * rs * gp[0], bf_hi(u[j]) * rs * gp[1]); }
    }
    {
      const uint2 u = *(const uint2*)(zr + 384 + 4 * lane);
      float v0 = bf_lo(u.x), v1 = bf_hi(u.x), v2 = bf_lo(u.y), v3 = bf_hi(u.y);
      float ss = wave_sum(v0 * v0 + v1 * v1 + v2 * v2 + v3 * v3); const float rs = rsqrtf(ss * (1.0f / 256.0f) + EPS);
      const float* gp = p.od_g_kva + 4 * lane; uint2 o; o.x = pk_bf16(v0 * rs * gp[0], v1 * rs * gp[1]); o.y = pk_bf16(v2 * rs * gp[2], v3 * rs * gp[3]);
      *(uint2*)(zr + 384 + 4 * lane) = o;
    }
    {
      const int b = r / T, t = r - b * T;
      const int pos = t < 16 ? t : p.pos[b * 4096 + (t - 16)] + 16;
      const int i = lane & 15;
      const float freq = exp2f(-(float)i * 0.8304820237218406f);
      const float ang = (float)pos * freq;
      double rev = (double)ang * 0.15915494309189535; rev -= rint(rev);
      const float rf = (float)rev;
      const float cs = __builtin_amdgcn_cosf(rf), sn = __builtin_amdgcn_sinf(rf);
      float v = lane < 32 ? bf2f(zr[640 + lane]) : 0.f;
      const float ss = wave_sum(v * v); const float rs = rsqrtf(ss * (1.0f / 32.0f) + EPS);
      const float kn = lane < 32 ? v * rs * p.od_g_kr[lane & 31] : 0.f;
      const float pt = __shfl_xor(kn, 16);
      const float o = lane < 16 ? kn * cs - pt * sn : pt * sn + kn * cs;
      if (lane < 32) KR[(size_t)r * 32 + lane] = f2bf(o);
      if (lane < 16) { ROPE[(size_t)r * 32 + lane] = cs; ROPE[(size_t)r * 32 + 16 + lane] = sn; }
    }
#pragma unroll
    for (int which = 0; which < 2; ++which) {
      bf16_t* base = zr + (which ? 1184 : 672) + 8 * lane; const float* gg = (which ? p.od_g_fk : p.od_g_fq) + 8 * (lane & 7);
      const uint4 u = *(const uint4*)base; const unsigned uu[4] = {u.x, u.y, u.z, u.w};
      float v[8]; float ss = 0.f;
#pragma unroll
      for (int j = 0; j < 4; ++j) { v[2 * j] = bf_lo(uu[j]); v[2 * j + 1] = bf_hi(uu[j]); ss += v[2 * j] * v[2 * j] + v[2 * j + 1] * v[2 * j + 1]; }
      ss += __shfl_xor(ss, 1); ss += __shfl_xor(ss, 2); ss += __shfl_xor(ss, 4);
      const float rs = rsqrtf(ss * (1.0f / 64.0f) + EPS);
      *(uint4*)base = make_uint4(pk_bf16(v[0] * rs * gg[0], v[1] * rs * gg[1]), pk_bf16(v[2] * rs * gg[2], v[3] * rs * gg[3]), pk_bf16(v[4] * rs * gg[4], v[5] * rs * gg[5]), pk_bf16(v[6] * rs * gg[6], v[7] * rs * gg[7]));
    }
    if (lane < 8) { float* gp = G + (size_t)r * 8 + lane; *gp = logsigmoidf_(*gp + p.od_b_f[lane]); }
  }
}

__device__ __forceinline__ void fcum_item(const Params& p, unsigned char* lds, int item) {
  const int tid = otid(), b = item >> 3, hh = item & 7;
  const float* G = (const float*)(p.ws + OFF_GATES);
  float* FC = (float*)(p.ws + OFF_FCUM) + (size_t)item * T;
  float* part = (float*)lds;
  float loc[9]; float s = 0.f;
#pragma unroll
  for (int k = 0; k < 9; ++k) { const int t = tid * 9 + k; loc[k] = t < T ? G[(size_t)(b * T + t) * 8 + hh] : 0.f; s += loc[k]; }
  __syncthreads();
  part[tid] = s;
  __syncthreads();
  float pre = 0.f;
  for (int i = 0; i < tid; ++i) pre += part[i];
#pragma unroll
  for (int k = 0; k < 9; ++k) { const int t = tid * 9 + k; pre += loc[k]; if (t < T) FC[t] = pre; }
  __syncthreads();
}

__device__ __forceinline__ void headprep_phase(const Params& p) {
  bf16_t* QR = (bf16_t*)(p.ws + OFF_QRAW); bf16_t* KV = (bf16_t*)(p.ws + OFF_KVRAW);
  const float* ROPE = (const float*)(p.ws + OFF_ROPE);
  const int gt = obid() * NT + otid(), nth = gridDim.x * NT;
  for (int idx = gt; idx < M * 8; idx += nth) {
    const int r = idx >> 3, hh = idx & 7;
    { bf16_t* qp = QR + (size_t)r * 768 + hh * 96;
      float v[96]; float s1 = 0.f, s2 = 0.f;
#pragma unroll
      for (int c = 0; c < 12; ++c) { const uint4 u = *(const uint4*)(qp + 8 * c); const unsigned uu[4] = {u.x, u.y, u.z, u.w};
#pragma unroll
        for (int j = 0; j < 4; ++j) { v[8 * c + 2 * j] = bf_lo(uu[j]); v[8 * c + 2 * j + 1] = bf_hi(uu[j]); } }
#pragma unroll
      for (int i = 0; i < 64; ++i) s1 += v[i] * v[i];
#pragma unroll
      for (int i = 64; i < 96; ++i) s2 += v[i] * v[i];
      const float r1 = rsqrtf(s1 * (1.0f / 64.0f) + EPS), r2 = rsqrtf(s2 * (1.0f / 32.0f) + EPS);
#pragma unroll
      for (int i = 0; i < 64; ++i) v[i] = v[i] * r1 * p.od_g_qn[i];
#pragma unroll
      for (int i = 0; i < 32; ++i) v[64 + i] = v[64 + i] * r2 * p.od_g_qr[i];
#pragma unroll
      for (int i = 0; i < 16; ++i) { const float cs = ROPE[(size_t)r * 32 + i], sn = ROPE[(size_t)r * 32 + 16 + i]; const float x1 = v[64 + i], x2 = v[80 + i]; v[64 + i] = x1 * cs - x2 * sn; v[80 + i] = x1 * sn + x2 * cs; }
#pragma unroll
      for (int c = 0; c < 12; ++c) *(uint4*)(qp + 8 * c) = make_uint4(pk_bf16(v[8 * c], v[8 * c + 1]), pk_bf16(v[8 * c + 2], v[8 * c + 3]), pk_bf16(v[8 * c + 4], v[8 * c + 5]), pk_bf16(v[8 * c + 6], v[8 * c + 7]));
    }
    { bf16_t* kp = KV + (size_t)r * 1024 + hh * 128;
      float v[64]; float s1 = 0.f;
#pragma unroll
      for (int c = 0; c < 8; ++c) { const uint4 u = *(const uint4*)(kp + 8 * c); const unsigned uu[4] = {u.x, u.y, u.z, u.w};
#pragma unroll
        for (int j = 0; j < 4; ++j) { v[8 * c + 2 * j] = bf_lo(uu[j]); v[8 * c + 2 * j + 1] = bf_hi(uu[j]); } }
#pragma unroll
      for (int i = 0; i < 64; ++i) s1 += v[i] * v[i];
      const float r1 = rsqrtf(s1 * (1.0f / 64.0f) + EPS);
#pragma unroll
      for (int i = 0; i < 64; ++i) v[i] = v[i] * r1 * p.od_g_kn[i];
#pragma unroll
      for (int c = 0; c < 8; ++c) *(uint4*)(kp + 8 * c) = make_uint4(pk_bf16(v[8 * c], v[8 * c + 1]), pk_bf16(v[8 * c + 2], v[8 * c + 3]), pk_bf16(v[8 * c + 4], v[8 * c + 5]), pk_bf16(v[8 * c + 6], v[8 * c + 7]));
    }
  }
}

#define XB_TMO      128
#define XB_XCNT(j)  (256  + 64 * (j))
#define XB_XSUB(j)  (1280 + 64 * (j))
#define XB_XGEN(j)  (2304 + 64 * (j))
#define XB_TOP      3328
#define XB_TOPGEN   3392
#define XCD_BAR_WORDS 3456
#define XB_SPIN_CAP (1u << 18)
#define LAS __attribute__((address_space(3)))

__device__ __forceinline__ unsigned xb_ld(unsigned* p)              { return __hip_atomic_load(p, __ATOMIC_RELAXED, __HIP_MEMORY_SCOPE_AGENT); }
__device__ __forceinline__ unsigned xb_add(unsigned* p, unsigned v) { return __hip_atomic_fetch_add(p, v, __ATOMIC_RELAXED, __HIP_MEMORY_SCOPE_AGENT); }
__device__ __forceinline__ unsigned xb_xcc_id() { return (unsigned)__builtin_amdgcn_s_getreg((3 << 11) | 20) & 0xFu; }
#define XB_SPIN(cond, bar) do { unsigned _sp = 0; while (cond) { __builtin_amdgcn_s_sleep(1); \
    if ((++_sp & 255u) == 0u) { if (xb_ld(&(bar)[XB_TMO])) break; if (_sp > XB_SPIN_CAP) { atomicAdd(&(bar)[XB_TMO], 1u); break; } } } } while (0)

struct XcdBarrier {
    unsigned* bar; unsigned x;
    volatile LAS unsigned* st;
};

__device__ __forceinline__ XcdBarrier xcd_barrier_post(unsigned* bar, volatile LAS unsigned* st) {
    XcdBarrier b; b.bar = bar; b.x = xb_xcc_id(); b.st = st;
    if (threadIdx.x == 0) (void)xb_add(&bar[XB_XCNT(b.x)], 1u);
    return b;
}
__device__ __forceinline__ void xcd_barrier_complete(unsigned* bar, unsigned x, unsigned& nloc, unsigned& nx) {
    const unsigned G = gridDim.x * gridDim.y * gridDim.z;
    unsigned sum, cnt, mine, sp = 0u;
    for (;;) {
        sum = 0u; cnt = 0u; mine = 0u;
#pragma unroll
        for (unsigned j = 0; j < 16; ++j) { const unsigned c = xb_ld(&bar[XB_XCNT(j)]); sum += c; cnt += (c > 0u) ? 1u : 0u; mine = (j == x) ? c : mine; }
        if (sum == G) break;
        __builtin_amdgcn_s_sleep(1);
        if ((++sp & 255u) == 0u) { if (xb_ld(&bar[XB_TMO])) break; if (sp > XB_SPIN_CAP) { atomicAdd(&bar[XB_TMO], 1u); break; } }
    }
    nloc = mine > 0u ? mine : 1u; nx = cnt > 0u ? cnt : 1u;
}

__device__ __forceinline__ void xcd_barrier(const XcdBarrier& b) {
    asm volatile("s_waitcnt vmcnt(0)" ::: "memory");
    __syncthreads();
    if (threadIdx.x == 0) {
        unsigned* bar = b.bar;
        __builtin_amdgcn_s_waitcnt(0);
        unsigned nloc = b.st[0], nx = b.st[1];
        if (nloc == 0u) { xcd_barrier_complete(bar, b.x, nloc, nx); b.st[0] = nloc; b.st[1] = nx; }
        const unsigned old = xb_add(&bar[XB_XSUB(b.x)], 1u);
        const unsigned gen = old / nloc;
        if (old + 1u == (gen + 1u) * nloc) {
            __builtin_amdgcn_fence(__ATOMIC_RELEASE, "agent");
            asm volatile("s_waitcnt vmcnt(0)" ::: "memory");
            const unsigned og = xb_add(&bar[XB_TOP], 1u);
            const unsigned tg = og / nx;
            if (og + 1u == (tg + 1u) * nx) xb_add(&bar[XB_TOPGEN], 1u);
            else XB_SPIN(xb_ld(&bar[XB_TOPGEN]) == tg, bar);
            __builtin_amdgcn_fence(__ATOMIC_ACQUIRE, "agent");
            xb_add(&bar[XB_XGEN(b.x)], 1u);
            asm volatile("s_waitcnt vmcnt(0)" ::: "memory");
        } else {
            XB_SPIN(xb_ld(&bar[XB_XGEN(b.x)]) == gen, bar);
            __builtin_amdgcn_fence(__ATOMIC_ACQUIRE, "agent");
            asm volatile("s_waitcnt vmcnt(0)" ::: "memory");
        }
    }
    __syncthreads();
}

template <int DK, bool BIAS>
__device__ __forceinline__ void attn_item(unsigned char* lds, const bf16_t* __restrict__ Qp, int ldq, const bf16_t* __restrict__ Kp, int ldk, const bf16_t* __restrict__ K2p, int ldk2,
                          const bf16_t* __restrict__ Vp, int ldv, const float* __restrict__ fc, bf16_t* __restrict__ Op, int b, int q0, int qend, int nkv, float scale) {
  constexpr int KS = DK / 32, KST = DK + 8, NCH = DK / 8, NPIECE = 64 * NCH;
  const int tid = otid(), w = tid >> 6, lane = tid & 63, fr = lane & 15, fq = lane >> 4;
  bf16_t* Ksm = (bf16_t*)lds;
  bf16_t* Vtm = Ksm + 2 * 64 * KST;
  float* fkm = (float*)(Vtm + 2 * 64 * 72);
  const int rowb = b * T;
  const bool wact = q0 + 32 * w < qend;
  bf16x8 qf[2][KS];
#pragma unroll
  for (int qi = 0; qi < 2; ++qi) {
    const int qg = q0 + 32 * w + 16 * qi + fr;
#pragma unroll
    for (int ks = 0; ks < KS; ++ks) { uint4 u = make_uint4(0, 0, 0, 0); if (qg < qend) u = *(const uint4*)(Qp + (size_t)(rowb + qg) * ldq + 32 * ks + 8 * fq); qf[qi][ks] = mk8u(u); }
  }
  f32x4 O[4][2];
#pragma unroll
  for (int et = 0; et < 4; ++et)
#pragma unroll
    for (int qi = 0; qi < 2; ++qi) O[et][qi] = (f32x4){0.f, 0.f, 0.f, 0.f};
  float mrun[2] = {-1e30f, -1e30f}, lrun[2] = {0.f, 0.f};
  uint4 rk0A, rk1A = make_uint4(0, 0, 0, 0), rvA, rk0B = make_uint4(0, 0, 0, 0), rk1B = make_uint4(0, 0, 0, 0), rvB = make_uint4(0, 0, 0, 0); float rfkA = 0.f, rfkB = 0.f;
  const int krow0 = tid / NCH, kch0 = tid - krow0 * NCH, krow1 = (tid + 512) / NCH, kch1 = (tid + 512) - krow1 * NCH;
  const int vrow = tid & 63, vch = tid >> 6;
  auto kload = [&](int kg, int chn) -> uint4 {
    uint4 u = make_uint4(0, 0, 0, 0);
    if (kg < T) { if (DK == 64 || chn < 8) u = *(const uint4*)(Kp + (size_t)(rowb + kg) * ldk + chn * 8); else u = *(const uint4*)(K2p + (size_t)(rowb + kg) * ldk2 + (chn - 8) * 8); }
    return u; };
  auto prefetch = [&](int j, uint4& rk0, uint4& rk1, uint4& rv, float& rfk) {
    rk0 = kload(64 * j + krow0, kch0);
    if (NPIECE > 512 && tid + 512 < NPIECE) rk1 = kload(64 * j + krow1, kch1);
    { const int kg = 64 * j + vrow; rv = make_uint4(0, 0, 0, 0); if (kg < T) rv = *(const uint4*)(Vp + (size_t)(rowb + kg) * ldv + vch * 8); }
    if (BIAS && tid < 64) { const int kg = 64 * j + tid; rfk = kg < T ? -fc[kg] * LOG2E : 0.f; }
  };
  auto stage = [&](int buf, const uint4& rk0, const uint4& rk1, const uint4& rv, const float& rfk) {
    *(uint4*)(Ksm + (buf * 64 + krow0) * KST + kch0 * 8) = rk0;
    if (NPIECE > 512 && tid + 512 < NPIECE) *(uint4*)(Ksm + (buf * 64 + krow1) * KST + kch1 * 8) = rk1;
    { const unsigned vv[4] = {rv.x, rv.y, rv.z, rv.w};
#pragma unroll
      for (int jj = 0; jj < 4; ++jj) { Vtm[(buf * 64 + vch * 8 + 2 * jj) * 72 + vrow] = (bf16_t)(vv[jj] & 0xffffu); Vtm[(buf * 64 + vch * 8 + 2 * jj + 1) * 72 + vrow] = (bf16_t)(vv[jj] >> 16); } }
    if (BIAS && tid < 64) fkm[buf * 64 + tid] = rfk;
  };
  __syncthreads();
  prefetch(0, rk0A, rk1A, rvA, rfkA); stage(0, rk0A, rk1A, rvA, rfkA);
  if (nkv > 1) prefetch(1, rk0B, rk1B, rvB, rfkB);
  __syncthreads();
  const float sc2 = scale * LOG2E;
  auto tile_step = [&](const int j, uint4& pk0, uint4& pk1, uint4& pv, float& pfk, const uint4& sk0, const uint4& sk1, const uint4& sv, const float& sfk) {
    const int buf = j & 1;
    if (j + 2 < nkv) prefetch(j + 2, pk0, pk1, pv, pfk);
    if (wact && 64 * j <= q0 + 32 * w + 31) {
      f32x4 S[4][2];
#pragma unroll
      for (int kt = 0; kt < 4; ++kt)
#pragma unroll
        for (int qi = 0; qi < 2; ++qi) S[kt][qi] = (f32x4){0.f, 0.f, 0.f, 0.f};
#pragma unroll
      for (int ks = 0; ks < KS; ++ks)
#pragma unroll
        for (int kt = 0; kt < 4; ++kt) { const bf16x8 ak = *(const bf16x8*)(Ksm + (buf * 64 + 16 * kt + fr) * KST + 32 * ks + 8 * fq);
#pragma unroll
          for (int qi = 0; qi < 2; ++qi) S[kt][qi] = MFMA(ak, qf[qi][ks], S[kt][qi]); }
      bf16x8 pf[2][2];
      if (64 * j + 63 > q0 + 32 * w) {
#pragma unroll
        for (int qi = 0; qi < 2; ++qi) { const int qg = q0 + 32 * w + 16 * qi + fr;
#pragma unroll
          for (int kt = 0; kt < 4; ++kt)
#pragma unroll
            for (int r = 0; r < 4; ++r) { const int kg = 64 * j + 16 * kt + 4 * fq + r; if (kg > qg) S[kt][qi][r] = -1e30f; } }
      }
#pragma unroll
      for (int qi = 0; qi < 2; ++qi) {
        float mx = -3e38f;
        if (BIAS) {
#pragma unroll
          for (int kt = 0; kt < 4; ++kt) { const f32x4 nf = *(const f32x4*)(fkm + buf * 64 + 16 * kt + 4 * fq);
#pragma unroll
            for (int r = 0; r < 4; ++r) { const float t = fmaf(S[kt][qi][r], sc2, nf[r]); S[kt][qi][r] = t; mx = fmaxf(mx, t); } }
        } else {
#pragma unroll
          for (int kt = 0; kt < 4; ++kt)
#pragma unroll
            for (int r = 0; r < 4; ++r) mx = fmaxf(mx, S[kt][qi][r]);
          mx *= sc2;
        }
        mx = fmaxf(mx, __shfl_xor(mx, 16)); mx = fmaxf(mx, __shfl_xor(mx, 32));
        const float mold = mrun[qi], mnew = fmaxf(mold, mx);
        mrun[qi] = mnew;
        float ps = 0.f;
#pragma unroll
        for (int kt = 0; kt < 4; ++kt)
#pragma unroll
          for (int r = 0; r < 4; ++r) { const float pv = BIAS ? __builtin_amdgcn_exp2f(S[kt][qi][r] - mnew) : __builtin_amdgcn_exp2f(fmaf(S[kt][qi][r], sc2, -mnew)); S[kt][qi][r] = pv; ps += pv; }
        {
          const float alpha = __builtin_amdgcn_exp2f(mold - mnew);
          lrun[qi] *= alpha;
#pragma unroll
          for (int et = 0; et < 4; ++et) O[et][qi] *= alpha;
        }
        lrun[qi] += ps;
#pragma unroll
        for (int k2 = 0; k2 < 2; ++k2) { uint2 lo, hi; lo.x = pk_bf16(S[2 * k2][qi][0], S[2 * k2][qi][1]); lo.y = pk_bf16(S[2 * k2][qi][2], S[2 * k2][qi][3]);
          hi.x = pk_bf16(S[2 * k2 + 1][qi][0], S[2 * k2 + 1][qi][1]); hi.y = pk_bf16(S[2 * k2 + 1][qi][2], S[2 * k2 + 1][qi][3]); pf[qi][k2] = mk8(lo, hi); }
      }
#pragma unroll
      for (int k2 = 0; k2 < 2; ++k2)
#pragma unroll
        for (int et = 0; et < 4; ++et) {
          const uint2 v0 = *(const uint2*)(Vtm + (buf * 64 + 16 * et + fr) * 72 + 32 * k2 + 4 * fq), v1 = *(const uint2*)(Vtm + (buf * 64 + 16 * et + fr) * 72 + 32 * k2 + 16 + 4 * fq);
          const bf16x8 va = mk8(v0, v1);
#pragma unroll
          for (int qi = 0; qi < 2; ++qi) O[et][qi] = MFMA(va, pf[qi][k2], O[et][qi]);
        }
    }
    if (j + 1 < nkv) stage(buf ^ 1, sk0, sk1, sv, sfk);
    LBAR();
  };
  for (int j = 0; j < nkv; j += 2) {
    tile_step(j, rk0A, rk1A, rvA, rfkA, rk0B, rk1B, rvB, rfkB);
    if (j + 1 < nkv) tile_step(j + 1, rk0B, rk1B, rvB, rfkB, rk0A, rk1A, rvA, rfkA);
  }
#pragma unroll
  for (int qi = 0; qi < 2; ++qi) {
    const int qg = q0 + 32 * w + 16 * qi + fr;
    float l = lrun[qi]; l += __shfl_xor(l, 16); l += __shfl_xor(l, 32);
    const float inv = 1.0f / l;
    if (qg < qend) {
#pragma unroll
      for (int et = 0; et < 4; ++et) { uint2 o; o.x = pk_bf16(O[et][qi][0] * inv, O[et][qi][1] * inv); o.y = pk_bf16(O[et][qi][2] * inv, O[et][qi][3] * inv);
        *(uint2*)(Op + (size_t)(rowb + qg) * 1024 + 16 * et + 4 * fq) = o; }
    }
  }
}

__device__ __forceinline__ void attn_phase(const Params& p, unsigned char* lds) {
  __shared__ int s_item;
  unsigned* ctr = (unsigned*)(p.ws + OFF_CTR);
  bf16_t* Zo = (bf16_t*)(p.ws + OFF_Z); bf16_t* QR = (bf16_t*)(p.ws + OFF_QRAW); bf16_t* KV = (bf16_t*)(p.ws + OFF_KVRAW);
  bf16_t* KR = (bf16_t*)(p.ws + OFF_KR); bf16_t* Y = (bf16_t*)(p.ws + OFF_YO);
  const float* FC = (const float*)(p.ws + OFF_FCUM);
  for (;;) {
    __syncthreads();
    if (otid() == 0) s_item = (int)atomicAdd(ctr, 1u);
    __syncthreads();
    const int it = s_item;
    if (it >= 17 * 128) break;
    const int k = 16 - it / 128, rem = it & 127, type = rem & 1, hh = (rem >> 1) & 7, b = rem >> 4;
    const int q0 = k ? 16 + 256 * (k - 1) : 0, qend = k ? q0 + 256 : 16, nkv = k ? 4 * k + 1 : 1;
    if (type == 0)
      attn_item<96, false>(lds, QR + hh * 96, 768, KV + hh * 128, 1024, KR, 32, KV + hh * 128 + 64, 1024, nullptr, Y + hh * 64, b, q0, qend, nkv, 0.10206207261596575f);
    else
      attn_item<64, true>(lds, Zo + 672 + hh * 64, LDZO, Zo + 1184 + hh * 64, LDZO, nullptr, 0, Zo + 1696 + hh * 64, LDZO, FC + (size_t)(b * 8 + hh) * T, Y + 512 + hh * 64, b, q0, qend, nkv, 0.125f);
  }
}

__device__ __forceinline__ void tail_norm(const Params& p, int nslab, bool first, float* __restrict__ ss, bf16_t* __restrict__ hb) {
  const int tid = otid(); const int lane = tid & 63, wave = (obid() * NT + tid) >> 6;
  if (wave < 128) {
    const int r = 32768 + wave; float* hp = hrow(p, r); const float* src = first ? xrow(p, r) : hp;
    float4 v[4];
#pragma unroll
    for (int i = 0; i < 4; ++i) v[i] = *(const float4*)(src + i * 256 + lane * 4);
    const float* sl = (const float*)(p.ws + OFF_SLAB) + (size_t)wave * 1024 + lane * 4;
    for (int sI = 0; sI < nslab; ++sI)
#pragma unroll
      for (int i = 0; i < 4; ++i) { const float4 a = *(const float4*)(sl + (size_t)sI * 131072 + i * 256); v[i].x += a.x; v[i].y += a.y; v[i].z += a.z; v[i].w += a.w; }
    float sq = 0.f;
#pragma unroll
    for (int i = 0; i < 4; ++i) { sq += v[i].x * v[i].x + v[i].y * v[i].y + v[i].z * v[i].z + v[i].w * v[i].w; *(float4*)(hp + i * 256 + lane * 4) = v[i];
      uint2 w; w.x = pk_bf16(v[i].x, v[i].y); w.y = pk_bf16(v[i].z, v[i].w); *(uint2*)(hb + (size_t)r * 1024 + i * 256 + lane * 4) = w; }
    sq = wave_sum(sq);
    if (lane == 0) ss[r] = sq;
  }
}

template <class Epi>
__device__ __forceinline__ void run_gemm(unsigned char* smem, const bf16_t* A, int lda, const bf16_t* Bt, int N, int K, const Epi& E) {
  pg8::Gemm g{A, Bt, MP, N, K, lda, K};
  pg8::StaticOrder S; S.init(MP, N, (int)gridDim.x, obid());
  pg8::gemm_phase<Epi, pg8::StaticOrder, true, true>((PG8_LAS unsigned char*)smem, g, S, E);
}

template <bool FIRST>
__device__ __forceinline__ void run_gemm_res(const Params& p, unsigned char* smem, const bf16_t* A, int lda, const bf16_t* Bt, int K, float* ss, bf16_t* hb) {
  { pg8::Gemm g{A, Bt, 32768, 1024, K, lda, K};
    pg8::StaticOrder S; S.init(32768, 1024, (int)gridDim.x, obid());
    pg8::gemm_phase<pg8::EpiRes<FIRST>, pg8::StaticOrder, true, true>((PG8_LAS unsigned char*)smem, g, S, pg8::EpiRes<FIRST>{&p, ss, hb}); }
  { const int c = obid(), ks = c >> 2;
    pg8::TailOrder TS{c, 4 * (K >> 8), 128};
    pg8::Gemm g{A + ks * 256, Bt + ks * 256, MP, 1024, 256, lda, K};
    pg8::gemm_phase<pg8::EpiSlab, pg8::TailOrder, true, true>((PG8_LAS unsigned char*)smem, g, TS, pg8::EpiSlab{(float*)(p.ws + OFF_SLAB), ks}); }
}

__global__ void __launch_bounds__(NT, 2) fwd_megakernel(Params p) {
  cg::grid_group grid = cg::this_grid();
  __shared__ __attribute__((aligned(16))) unsigned char smem[SMEM_BYTES];
  unsigned char* ws = p.ws;
  bf16_t* XN = (bf16_t*)(ws + OFF_XN); bf16_t* Z = (bf16_t*)(ws + OFF_Z); float* GATES = (float*)(ws + OFF_GATES);
  __shared__ uint4 xb_words;
  if (threadIdx.x == 0) xb_words = make_uint4(0u, 0u, 0u, 0u);
  unsigned* barw = (unsigned*)(ws + OFF_BAR);
  if (blockIdx.x == 0) { for (int i = threadIdx.x; i < XCD_BAR_WORDS; i += NT) barw[i] = 0u; if (threadIdx.x == 0) *(unsigned*)(ws + OFF_CTR) = 0u; }
  float* SS = (float*)(ws + OFF_SS);
  for (int i = blockIdx.x * NT + threadIdx.x; i < 3 * MP; i += gridDim.x * NT) SS[i] = 0.f;
  wconv(smem, p.ev_w_in, (bf16_t*)(ws + OFF_WINE), 1024, 5128, 5376, 1, 1);
  wconv(smem, p.ev_w_out, (bf16_t*)(ws + OFF_WOUTE), 2048, 1024, 1024, 0, 1);
  wconv(smem, p.w_ff1, (bf16_t*)(ws + OFF_FF1), 1024, 4096, 4096, 0, 2, p.mlp_ln);
  wconv(smem, p.w_ff2, (bf16_t*)(ws + OFF_FF2), 4096, 1024, 1024, 0, 2);
  wconv(smem, p.od_w_in, (bf16_t*)(ws + OFF_WINO), 1024, 2216, 2304, 0, 1, p.od_ln);
  wconv(smem, p.od_w_uq, (bf16_t*)(ws + OFF_WUQ), 384, 768, 768, 0, 1);
  wconv(smem, p.od_w_ukv, (bf16_t*)(ws + OFF_WUKV), 256, 1024, 1024, 0, 1);
  wconv(smem, p.od_w_out, (bf16_t*)(ws + OFF_WOUTO), 1024, 1024, 1024, 0, 1);
  wconv(smem, p.ev_w_ra, (bf16_t*)(ws + OFF_WRA), 128, 128, 128, 0, 8);
  wconv(smem, p.ev_w_rx, (bf16_t*)(ws + OFF_WRX), 128, 128, 128, 0, 8);
  norm_phase(p, p.ev_ln, 1, 0);
  grid.sync();
  (void)xcd_barrier_post(barw, (volatile LAS unsigned*)&xb_words);
#define GSYNC() do { XcdBarrier xb_; xb_.bar = (unsigned*)(p.ws + OFF_BAR); xb_.x = xb_xcc_id(); xb_.st = (volatile LAS unsigned*)&xb_words; xcd_barrier(xb_); } while (0)
  run_gemm(smem, XN, 1024, (const bf16_t*)(ws + OFF_WINE), 5376, 1024, pg8::EpiZ<0>{Z, LDZE, 5120, GATES, nullptr});
  GSYNC();
  {
    __shared__ unsigned hbar_cnt[2];
    const int tid = otid(), half = tid >> 8, lt = tid & 255;
    __syncthreads(); if (tid < 2) hbar_cnt[tid] = 0u; __syncthreads();
    unsigned hgen = 0u; unsigned* hcnt = &hbar_cnt[half];
    const int G = (int)gridDim.x;
    for (int pr = obid(); pr < 128; pr += G) mlstm_item(p, smem + half * HALF_LDS, 2 * pr + half, lt, hcnt, hgen);
    { const int b0 = obid();
      for (int pr = b0 >= 128 ? b0 : b0 + G * ((127 - b0) / G + 1); pr < 256; pr += G) rglru_item(p, smem + half * HALF_LDS, 2 * (pr - 128) + half, lt, hcnt, hgen); }
  }
  GSYNC();
  anorm_phase(p);
  GSYNC();
  run_gemm_res<true>(p, smem, Z + 3072, LDZE, (const bf16_t*)(ws + OFF_WOUTE), 2048, SS, XN);
  GSYNC();
  for (int layer = 0; layer < 2; ++layer) {
    if (layer == 1) {
      tail_norm(p, 16, false, SS + MP, XN);
      GSYNC();
      run_gemm(smem, XN, 1024, (const bf16_t*)(ws + OFF_WINO), 2304, 1024, pg8::EpiZ<0>{Z, LDZO, 2208, GATES, SS + MP});
      GSYNC();
      oddprep_phase(p);
      GSYNC();
      run_gemm(smem, Z, LDZO, (const bf16_t*)(ws + OFF_WUQ), 768, 384, pg8::EpiZ<0>{(bf16_t*)(ws + OFF_QRAW), 768, 1 << 30, nullptr, nullptr});
      run_gemm(smem, Z + 384, LDZO, (const bf16_t*)(ws + OFF_WUKV), 1024, 256, pg8::EpiZ<0>{(bf16_t*)(ws + OFF_KVRAW), 1024, 1 << 30, nullptr, nullptr});
      for (int it = obid(); it < 64; it += gridDim.x) fcum_item(p, smem, it);
      GSYNC();
      headprep_phase(p);
      GSYNC();
      attn_phase(p, smem);
      GSYNC();
      run_gemm_res<false>(p, smem, (const bf16_t*)(ws + OFF_YO), 1024, (const bf16_t*)(ws + OFF_WOUTO), 1024, SS + 2 * MP, XN);
      GSYNC();
    }
    tail_norm(p, layer ? 4 : 8, layer == 0, SS + (layer ? 2 * MP : 0), XN);
    GSYNC();
    run_gemm(smem, XN, 1024, (const bf16_t*)(ws + OFF_FF1) + (size_t)layer * 4096 * 1024, 4096, 1024, pg8::EpiZ<1>{Z, 4096, 1 << 30, nullptr, SS + (layer ? 2 * MP : 0)});
    GSYNC();
    run_gemm_res<false>(p, smem, Z, 4096, (const bf16_t*)(ws + OFF_FF2) + (size_t)layer * 4096 * 1024, 4096, layer ? nullptr : SS + MP, XN);
    GSYNC();
  }
  {
    const int tid = otid(), lane = tid & 63, wave = (obid() * NT + tid) >> 6;
    if (wave < 128) { const int r = 32768 + wave; float* hp = hrow(p, r);
      const float* sl = (const float*)(ws + OFF_SLAB) + (size_t)wave * 1024 + lane * 4;
#pragma unroll
      for (int i = 0; i < 4; ++i) { float4 v = *(const float4*)(hp + i * 256 + lane * 4);
        for (int sI = 0; sI < 16; ++sI) { const float4 a = *(const float4*)(sl + (size_t)sI * 131072 + i * 256); v.x += a.x; v.y += a.y; v.z += a.z; v.w += a.w; }
        *(float4*)(hp + i * 256 + lane * 4) = v; } }
  }
}

extern "C" void kernel_launch(void* const* d_in, const int* in_sizes, int n_in, void* d_out, int out_size,
                              void* d_ws, size_t ws_size, hipStream_t stream) {
  static int grid_blocks = 0;
  if (!grid_blocks) {
    int dev = 0, cus = 0, per_cu = 0;
    (void)hipGetDevice(&dev);
    (void)hipDeviceGetAttribute(&cus, hipDeviceAttributeMultiprocessorCount, dev);
    (void)hipOccupancyMaxActiveBlocksPerMultiprocessor(&per_cu, fwd_megakernel, NT, 0);
    if (per_cu > 1) per_cu = 1;
    if (per_cu < 1) per_cu = 1;
    grid_blocks = cus * per_cu;
  }
  Params p{};
  const float** fp = (const float**)&p;
  (void)fp;
  p.x = (const float*)d_in[0]; p.pos = (const int*)d_in[1]; p.meta = (const float*)d_in[2];
  p.ev_ln = (const float*)d_in[3]; p.ev_w_in = (const float*)d_in[4]; p.ev_b_if = (const float*)d_in[5]; p.ev_a_norm = (const float*)d_in[6];
  p.ev_conv_w = (const float*)d_in[7]; p.ev_conv_b = (const float*)d_in[8]; p.ev_w_ra = (const float*)d_in[9]; p.ev_b_ra = (const float*)d_in[10];
  p.ev_w_rx = (const float*)d_in[11]; p.ev_b_rx = (const float*)d_in[12]; p.ev_lam = (const float*)d_in[13]; p.ev_w_out = (const float*)d_in[14];
  p.od_ln = (const float*)d_in[15]; p.od_w_in = (const float*)d_in[16]; p.od_b_f = (const float*)d_in[17]; p.od_g_qa = (const float*)d_in[18];
  p.od_g_kva = (const float*)d_in[19]; p.od_w_uq = (const float*)d_in[20]; p.od_w_ukv = (const float*)d_in[21]; p.od_g_qn = (const float*)d_in[22];
  p.od_g_qr = (const float*)d_in[23]; p.od_g_kn = (const float*)d_in[24]; p.od_g_kr = (const float*)d_in[25]; p.od_g_fq = (const float*)d_in[26];
  p.od_g_fk = (const float*)d_in[27]; p.od_w_out = (const float*)d_in[28];
  p.mlp_ln = (const float*)d_in[29]; p.w_ff1 = (const float*)d_in[30]; p.w_ff2 = (const float*)d_in[31];
  p.out = (float*)d_out; p.ws = (unsigned char*)d_ws;
  void* args[] = {&p};
  hipError_t e = hipLaunchCooperativeKernel((void*)fwd_megakernel, dim3(grid_blocks), dim3(NT), args, 0, stream);
  if (e != hipSuccess) fprintf(stderr, "cooperative launch failed: %s (grid %d)\n", hipGetErrorString(e), grid_blocks);
}
```

```cpp
#include <hip/hip_runtime.h>
#include <hip/hip_cooperative_groups.h>
#include <cstdio>
#include <cstdint>
namespace cg = cooperative_groups;
namespace pg8 {
#define PG8_LAS __attribute__((address_space(3)))
typedef unsigned short bf16_t;
typedef short bf16x8 __attribute__((ext_vector_type(8)));
typedef float f32x4 __attribute__((ext_vector_type(4)));
typedef unsigned u32x4 __attribute__((ext_vector_type(4)));
constexpr int BM = 256, BK = 64, HALF = 128, HTB = HALF * BK * 2  , STAGE_BYTES = 8 * HTB, NXCD = 8, WGM = 8;

__host__ __device__ __forceinline__ int lds_byte(int r, int c) { const int st = (r >> 4) * 2 + (c >> 5), rr = r & 15, cc = c & 31, ob = rr * 64 + cc * 2; return st * 1024 + (ob ^ (((ob >> 9) & 1) << 5)); }
__host__ __device__ __forceinline__ void stage_rc(int b, int& R, int& C) { const int st = b / 1024, sb = b % 1024, swz = sb ^ (((sb >> 9) & 1) << 5); R = (st >> 1) * 16 + swz / 64; C = (st & 1) * 32 + (swz % 64) / 2; }
__host__ __device__ __forceinline__ int perm32(int rho) { const int n = rho >> 4, i = rho & 15; return 8 * (i >> 2) + 4 * n + (i & 3); }

struct Unit { int pm, pn; };
struct Gemm { const bf16_t* A; const bf16_t* Bt; int M, N, K, lda, ldb; };

struct StaticOrder {
    int nM, nN, nwg, G, c;
    __host__ __device__ void init(int M, int N, int G_, int c_) { nM = M / BM; nN = N / BM; nwg = nM * nN; G = G_; c = c_; }
    __host__ __device__ bool next(int i, Unit& u) const {
        const long L = (long)i * G + c; if (L >= nwg) return false;
        int wgid = (int)L; { const int q = nwg / NXCD, r = nwg % NXCD, xcd = wgid % NXCD, off = wgid / NXCD; wgid = (xcd < r ? xcd * (q + 1) : r * (q + 1) + (xcd - r) * q) + off; }
        const int nig = WGM * nN, gid = wgid / nig, fm = gid * WGM, gsz = (nM - fm) < WGM ? (nM - fm) : WGM;
        u.pm = fm + ((wgid % nig) % gsz); u.pn = (wgid % nig) / gsz; return true;
    }
    __device__ __forceinline__ void a_ready(const Unit&) const {}
    __device__ __forceinline__ void done(const Unit&) const {}
};
}
using pg8::bf16_t; using pg8::bf16x8; using pg8::f32x4;
#define DEVI __device__ __forceinline__

constexpr int T = 4112, NB = 8, M = NB * T, MP = 33024, NT = 512;
constexpr float EPS = 1e-6f;
constexpr float LOG2E = 1.4426950408889634f;

struct Params {
  const float *x; const int* pos; const float* meta;
  const float *ev_ln, *ev_w_in, *ev_b_if, *ev_a_norm, *ev_conv_w, *ev_conv_b, *ev_w_ra, *ev_b_ra, *ev_w_rx, *ev_b_rx, *ev_lam, *ev_w_out;
  const float *od_ln, *od_w_in, *od_b_f, *od_g_qa, *od_g_kva, *od_w_uq, *od_w_ukv, *od_g_qn, *od_g_qr, *od_g_kn, *od_g_kr, *od_g_fq, *od_g_fk, *od_w_out;
  const float *mlp_ln, *w_ff1, *w_ff2;
  float* out; unsigned char* ws;
};

constexpr size_t OFF_WINE  = 0;
constexpr size_t OFF_WOUTE = OFF_WINE + (size_t)5376 * 1024 * 2;
constexpr size_t OFF_FF1   = OFF_WOUTE + (size_t)1024 * 2048 * 2;
constexpr size_t OFF_FF2   = OFF_FF1 + (size_t)2 * 4096 * 1024 * 2;
constexpr size_t OFF_WINO  = OFF_FF2 + (size_t)2 * 4096 * 1024 * 2;
constexpr size_t OFF_WUQ   = OFF_WINO + (size_t)2304 * 1024 * 2;
constexpr size_t OFF_WUKV  = OFF_WUQ + (size_t)768 * 384 * 2;
constexpr size_t OFF_WOUTO = OFF_WUKV + (size_t)1024 * 256 * 2;
constexpr size_t OFF_WRA   = OFF_WOUTO + (size_t)1024 * 1024 * 2;
constexpr size_t OFF_WRX   = OFF_WRA + 262144;
constexpr size_t OFF_HMETA = OFF_WRX + 262144;
constexpr size_t OFF_GATES = OFF_HMETA + 524288;
constexpr size_t OFF_CTR   = OFF_GATES + (size_t)MP * 8 * 4;
constexpr size_t OFF_BAR   = OFF_CTR + 256;
constexpr size_t OFF_XN    = OFF_BAR + 14336;
constexpr size_t OFF_Z     = OFF_XN + (size_t)MP * 1024 * 2;
constexpr int LDZE = 5120;
constexpr int LDZO = 2304;
constexpr size_t OFF_QRAW  = OFF_Z + (size_t)MP * LDZO * 2;
constexpr size_t OFF_KVRAW = OFF_QRAW + (size_t)MP * 768 * 2;
constexpr size_t OFF_KR    = OFF_KVRAW + (size_t)MP * 1024 * 2;
constexpr size_t OFF_ROPE  = OFF_KR + (size_t)MP * 32 * 2;
constexpr size_t OFF_FCUM  = OFF_ROPE + (size_t)MP * 32 * 4;

constexpr size_t OFF_SLAB  = OFF_Z + (size_t)MP * LDZE * 2;
constexpr int HALF_LDS = 69632, SMEM_BYTES = 2 * HALF_LDS;

DEVI unsigned pk_bf16(float lo, float hi) { unsigned r; asm("v_cvt_pk_bf16_f32 %0, %1, %2" : "=v"(r) : "v"(lo), "v"(hi)); return r; }
DEVI float bf_lo(unsigned u) { return __uint_as_float(u << 16); }
DEVI float bf_hi(unsigned u) { return __uint_as_float(u & 0xffff0000u); }
DEVI float bf2f(bf16_t v) { return __uint_as_float(((unsigned)v) << 16); }
DEVI bf16_t f2bf(float f) { return (bf16_t)(pk_bf16(f, 0.f) & 0xffffu); }
DEVI int otid() { int t = threadIdx.x; asm volatile("" : "+v"(t)); return t; }
DEVI int obid() { int t = blockIdx.x; asm volatile("" : "+s"(t)); return t; }
DEVI float wave_sum(float v) { for (int o = 32; o; o >>= 1) v += __shfl_xor(v, o); return v; }
DEVI float sigmoidf_(float x) { return __builtin_amdgcn_rcpf(1.0f + __builtin_amdgcn_exp2f(-x * LOG2E)); }
DEVI float logsigmoidf_(float x) { return fminf(x, 0.f) - 0.6931471805599453f * __builtin_amdgcn_logf(1.0f + __builtin_amdgcn_exp2f(-fabsf(x) * LOG2E)); }
DEVI float neg_expm1_small(float x) { float q = 1.0f / 5040.0f; q = q * x + 1.0f / 720.0f; q = q * x + 1.0f / 120.0f; q = q * x + 1.0f / 24.0f; q = q * x + 1.0f / 6.0f; q = q * x + 0.5f; q = q * x + 1.0f; return -x * q; }
DEVI float* hrow(const Params& p, int r) {
  const int b = r / T, t = r - b * T;
  return t < 16 ? (float*)(p.ws + OFF_HMETA) + (size_t)(b * 16 + t) * 1024 : p.out + ((size_t)b * 4096 + (t - 16)) * 1024;
}
DEVI const float* xrow(const Params& p, int r) { const int b = r / T, t = r - b * T; return t < 16 ? p.meta + (size_t)t * 1024 : p.x + ((size_t)b * 4096 + (t - 16)) * 1024; }
DEVI bf16x8 mk8(uint2 a, uint2 b) { union { uint4 u; bf16x8 v; } c; c.u = make_uint4(a.x, a.y, b.x, b.y); return c.v; }
DEVI bf16x8 mk8u(uint4 a) { union { uint4 u; bf16x8 v; } c; c.u = a; return c.v; }
#define LBAR() do { asm volatile("s_waitcnt lgkmcnt(0)" ::: "memory"); __builtin_amdgcn_s_barrier(); asm volatile("" ::: "memory"); } while (0)
#define HBAR() do { asm volatile("s_waitcnt lgkmcnt(0)" ::: "memory"); hgen += 4u; \
    if (lane == 0) { (void)__hip_atomic_fetch_add(hcnt, 1u, __ATOMIC_RELAXED, __HIP_MEMORY_SCOPE_WORKGROUP); \
      while (__hip_atomic_load(hcnt, __ATOMIC_RELAXED, __HIP_MEMORY_SCOPE_WORKGROUP) < hgen) __builtin_amdgcn_s_sleep(1); } \
    asm volatile("" ::: "memory"); } while (0)
#define MFMA(a, b, c) __builtin_amdgcn_mfma_f32_16x16x32_bf16((a), (b), (c), 0, 0, 0)


namespace pg8 {
template <int ACT> struct EpiZ {
    static constexpr bool PERM = true, AFTER_DRAIN = false;
    bf16_t* O; int ldo; int gate0; float* gates;
    __device__ __forceinline__ void operator()(const f32x4 (&acc)[2][2][4][2], const Unit& u, int wr, int wc, int fr, int fq) const {
        const int row0 = u.pm * BM + wr * 64 + fr, col0 = u.pn * BM + wc * 32 + 8 * fq;
#pragma unroll
        for (int ai = 0; ai < 2; ++ai)
#pragma unroll
            for (int m = 0; m < 4; ++m) { const int row = row0 + ai * HALF + m * 16;
#pragma unroll
                for (int bj = 0; bj < 2; ++bj) { const int col = col0 + bj * HALF; f32x4 v0 = acc[ai][bj][m][0], v1 = acc[ai][bj][m][1];
                    if (ACT == 1) {
#pragma unroll
                        for (int j = 0; j < 4; ++j) { const float a = fmaxf(v0[j], 0.f), b = fmaxf(v1[j], 0.f); v0[j] = a * a; v1[j] = b * b; } }
                    if (col < gate0) { u32x4 w; w.x = pk_bf16(v0[0], v0[1]); w.y = pk_bf16(v0[2], v0[3]); w.z = pk_bf16(v1[0], v1[1]); w.w = pk_bf16(v1[2], v1[3]); *(u32x4*)(O + (size_t)row * ldo + col) = w; }
                    else if (col < gate0 + 8) { float* gp = gates + (size_t)row * 8; *(f32x4*)gp = v0; *(f32x4*)(gp + 4) = v1; } } }
    }
};
template <bool FIRST> struct EpiRes {
    static constexpr bool PERM = false, AFTER_DRAIN = false;
    const Params* p;
    __device__ __forceinline__ void operator()(const f32x4 (&acc)[2][2][4][2], const Unit& u, int wr, int wc, int fr, int fq) const {
        const int row0 = u.pm * BM + wr * 64 + fr, col0 = u.pn * BM + wc * 32 + 4 * fq;
#pragma unroll
        for (int ai = 0; ai < 2; ++ai)
#pragma unroll
            for (int m = 0; m < 4; ++m) { const int row = row0 + ai * HALF + m * 16;
                if (row < M) { float* hp = hrow(*p, row) + col0; const float* sp = FIRST ? xrow(*p, row) + col0 : hp;
#pragma unroll
                    for (int bj = 0; bj < 2; ++bj)
#pragma unroll
                        for (int n = 0; n < 2; ++n) { f32x4 h = *(const f32x4*)(sp + bj * HALF + n * 16); h += acc[ai][bj][m][n]; *(f32x4*)(hp + bj * HALF + n * 16) = h; } } }
    }
};

struct EpiSlab {
    static constexpr bool PERM = false, AFTER_DRAIN = false;
    float* slab; int ks;
    __device__ __forceinline__ void operator()(const f32x4 (&acc)[2][2][4][2], const Unit& u, int wr, int wc, int fr, int fq) const {
        const int col0 = u.pn * BM + wc * 32 + 4 * fq;
#pragma unroll
        for (int m = 0; m < 4; ++m) { float* sp = slab + ((size_t)(ks * 128 + wr * 64 + m * 16 + fr)) * 1024 + col0;
#pragma unroll
            for (int bj = 0; bj < 2; ++bj)
#pragma unroll
                for (int n = 0; n < 2; ++n) *(f32x4*)(sp + bj * HALF + n * 16) = acc[0][bj][m][n]; }
    }
};
struct TailOrder {
    int c, n, pm;
    __device__ __forceinline__ bool next(int i, Unit& u) const { if (i != 0 || c >= n) return false; u.pm = pm; u.pn = c & 3; return true; }
    __device__ __forceinline__ void a_ready(const Unit&) const {}
    __device__ __forceinline__ void done(const Unit&) const {}
};
template <class Epi, class Sched, bool ALIGN_EPI = false, bool SP2 = false>
__device__ __forceinline__ void gemm_phase(PG8_LAS unsigned char* lds, const Gemm g, const Sched& S, const Epi& E) {
    const int tid = otid(), wid = __builtin_amdgcn_readfirstlane(tid >> 6), lane = tid & 63, wr = wid >> 2, wc = wid & 3, fr = lane & 15, fq = lane >> 4;
    const int K = g.K, nt = K / BK;
    unsigned voffA[2], voffB[2];
#pragma unroll
    for (int i = 0; i < 2; ++i) { int R, C; stage_rc(tid * 16 + i * 8192, R, C); const int Rb = Epi::PERM ? ((R & ~31) + perm32(R & 31)) : R;
        voffA[i] = (unsigned)(R * g.lda + C) * 2u; voffB[i] = (unsigned)(Rb * g.ldb + C) * 2u; }
    const size_t kstep = (size_t)(BK * 2);
    const size_t hstepA = (size_t)HALF * g.lda * 2, hstepB = (size_t)HALF * g.ldb * 2;
    const size_t tstepA = 2 * hstepA, tstepB = 2 * hstepB;
    const unsigned ldsw = (unsigned)wid * 1024u;
    const int aoff = lds_byte(wr * 64 + fr, fq * 8), boff = lds_byte(wc * 32 + fr, fq * 8);
#define PG8_SA(b, h) (((b) * 2 + (h)) * HTB)
#define PG8_SB(b, h) ((4 + (b) * 2 + (h)) * HTB)
#define PG8_STAGE(bufoff, gbase, voff) do { _Pragma("unroll") for (int _i = 0; _i < 2; ++_i) \
        __builtin_amdgcn_global_load_lds((const unsigned*)((const char*)(gbase) + (voff)[_i]), (PG8_LAS unsigned*)(lds + (bufoff) + ldsw + _i * 8192), 16, 0, 0); } while (0)
#define PG8_LDA(dst, b, h) do { _Pragma("unroll") for (int m = 0; m < 4; ++m) _Pragma("unroll") for (int k = 0; k < 2; ++k) dst[m][k] = *(const PG8_LAS bf16x8*)(lds + PG8_SA(b, h) + aoff + m * 2048 + k * 1024); } while (0)
#define PG8_LDB(dst, b, h) do { _Pragma("unroll") for (int n = 0; n < 2; ++n) _Pragma("unroll") for (int k = 0; k < 2; ++k) dst[n][k] = *(const PG8_LAS bf16x8*)(lds + PG8_SB(b, h) + boff + n * 2048 + k * 1024); } while (0)
#define PG8_MMA(ai, bj, At, Bt) do { __builtin_amdgcn_s_setprio(1); _Pragma("unroll") for (int m = 0; m < 4; ++m) _Pragma("unroll") for (int n = 0; n < 2; ++n) _Pragma("unroll") for (int k = 0; k < 2; ++k) \
        acc[ai][bj][m][n] = __builtin_amdgcn_mfma_f32_16x16x32_bf16(Bt[n][k], At[m][k], acc[ai][bj][m][n], 0, 0, 0); __builtin_amdgcn_s_setprio(0); } while (0)
#define PG8_WAIT_V(n) asm volatile("s_waitcnt vmcnt(" #n ")" ::: "memory")
#define PG8_WAIT_L(n) asm volatile("s_waitcnt lgkmcnt(" #n ")" ::: "memory")
#define PG8_BAR __builtin_amdgcn_s_barrier()
#define PG8_SCHED __builtin_amdgcn_sched_barrier(0)
    Unit cur, nxt; int ui = 0;
    if (!S.next(0, cur)) return;
    f32x4 acc[2][2][4][2];
#pragma unroll
    for (int a = 0; a < 2; ++a)
#pragma unroll
        for (int b = 0; b < 2; ++b)
#pragma unroll
            for (int m = 0; m < 4; ++m)
#pragma unroll
                for (int n = 0; n < 2; ++n) acc[a][b][m][n] = (f32x4){0.f, 0.f, 0.f, 0.f};
    bf16x8 At[4][2], B0[2][2], B1[2][2];
    const char* cA = (const char*)g.A + (size_t)cur.pm * tstepA; const char* cB = (const char*)g.Bt + (size_t)cur.pn * tstepB;
    S.a_ready(cur);
    if constexpr (SP2) {
        PG8_STAGE(PG8_SB(0, 0), cB, voffB); PG8_STAGE(PG8_SB(0, 1), cB + hstepB, voffB); PG8_STAGE(PG8_SA(0, 0), cA, voffA); PG8_STAGE(PG8_SA(0, 1), cA + hstepA, voffA);
        if (wr == 1) PG8_BAR;
        PG8_WAIT_V(2); PG8_BAR;
        PG8_STAGE(PG8_SB(1, 0), cB + kstep, voffB); PG8_STAGE(PG8_SA(1, 0), cA + kstep, voffA); PG8_STAGE(PG8_SB(1, 1), cB + hstepB + kstep, voffB);
        PG8_WAIT_V(6); PG8_BAR;
    } else {
        PG8_STAGE(PG8_SB(0, 0), cB, voffB); PG8_STAGE(PG8_SA(0, 0), cA, voffA); PG8_STAGE(PG8_SB(0, 1), cB + hstepB, voffB); PG8_STAGE(PG8_SA(0, 1), cA + hstepA, voffA);
        if (wr == 1) PG8_BAR;
        PG8_WAIT_V(4); PG8_BAR;
        PG8_STAGE(PG8_SB(1, 0), cB + kstep, voffB); PG8_STAGE(PG8_SA(1, 0), cA + kstep, voffA); PG8_STAGE(PG8_SB(1, 1), cB + hstepB + kstep, voffB);
        PG8_WAIT_V(6); PG8_BAR;
    }
    for (;;) {
        const bool has_next = S.next(ui + 1, nxt);
        const char* nA = has_next ? (const char*)g.A + (size_t)nxt.pm * tstepA : cA; const char* nB = has_next ? (const char*)g.Bt + (size_t)nxt.pn * tstepB : cB;
        for (int t = 0; t < nt; t += 2) {
            const bool last = (t == nt - 2);
            const char* a1 = cA + (size_t)(t + 1) * kstep;
            const char* a2 = last ? nA : cA + (size_t)(t + 2) * kstep; const char* b2 = last ? nB : cB + (size_t)(t + 2) * kstep;
            const char* a3 = a2 + kstep; const char* b3 = b2 + kstep;
            if (last && has_next) S.a_ready(nxt);
            if constexpr (SP2) {
            PG8_LDB(B0, 0, 0); PG8_LDB(B1, 0, 1); PG8_SCHED; PG8_LDA(At, 0, 0); PG8_STAGE(PG8_SA(1, 1), a1 + hstepA, voffA);
            PG8_WAIT_V(8); PG8_WAIT_L(0); PG8_BAR; PG8_MMA(0, 0, At, B0); PG8_MMA(0, 1, At, B1); PG8_BAR; PG8_SCHED;
            PG8_LDA(At, 0, 1); PG8_STAGE(PG8_SB(0, 0), b2, voffB); PG8_STAGE(PG8_SB(0, 1), b2 + hstepB, voffB); PG8_STAGE(PG8_SA(0, 0), a2, voffA);
            PG8_WAIT_V(8); PG8_WAIT_L(0); PG8_BAR; PG8_MMA(1, 0, At, B0); PG8_MMA(1, 1, At, B1); PG8_BAR; PG8_SCHED;
            PG8_LDB(B0, 1, 0); PG8_LDB(B1, 1, 1); PG8_SCHED; PG8_LDA(At, 1, 0); PG8_STAGE(PG8_SA(0, 1), a2 + hstepA, voffA);
            PG8_WAIT_V(8); PG8_WAIT_L(0); PG8_BAR; PG8_MMA(0, 0, At, B0); PG8_MMA(0, 1, At, B1); PG8_BAR; PG8_SCHED;
            PG8_LDA(At, 1, 1); PG8_STAGE(PG8_SB(1, 0), b3, voffB); PG8_STAGE(PG8_SB(1, 1), b3 + hstepB, voffB); PG8_STAGE(PG8_SA(1, 0), a3, voffA);
            PG8_WAIT_V(8); PG8_WAIT_L(0); PG8_BAR; PG8_MMA(1, 0, At, B0); PG8_MMA(1, 1, At, B1); PG8_BAR; PG8_SCHED;
            } else {
            PG8_LDB(B0, 0, 0); PG8_SCHED; PG8_LDA(At, 0, 0); PG8_STAGE(PG8_SA(1, 1), a1 + hstepA, voffA);
            PG8_WAIT_L(8); PG8_BAR; PG8_WAIT_L(0); PG8_MMA(0, 0, At, B0); PG8_BAR; PG8_SCHED;
            PG8_LDB(B1, 0, 1); PG8_STAGE(PG8_SB(0, 0), b2, voffB);
            PG8_BAR; PG8_WAIT_L(0); PG8_MMA(0, 1, At, B1); PG8_BAR;
            PG8_LDA(At, 0, 1); PG8_STAGE(PG8_SA(0, 0), a2, voffA);
            PG8_BAR; PG8_WAIT_L(0); PG8_MMA(1, 0, At, B0); PG8_BAR; PG8_SCHED;
            PG8_STAGE(PG8_SB(0, 1), b2 + hstepB, voffB);
            PG8_WAIT_V(6); PG8_BAR; PG8_MMA(1, 1, At, B1); PG8_BAR;
            PG8_LDB(B0, 1, 0); PG8_SCHED; PG8_LDA(At, 1, 0); PG8_STAGE(PG8_SA(0, 1), a2 + hstepA, voffA);
            PG8_WAIT_L(8); PG8_BAR; PG8_WAIT_L(0); PG8_MMA(0, 0, At, B0); PG8_BAR; PG8_SCHED;
            PG8_LDB(B1, 1, 1); PG8_STAGE(PG8_SB(1, 0), b3, voffB);
            PG8_BAR; PG8_WAIT_L(0); PG8_MMA(0, 1, At, B1); PG8_BAR;
            PG8_LDA(At, 1, 1); PG8_STAGE(PG8_SA(1, 0), a3, voffA);
            PG8_BAR; PG8_WAIT_L(0); PG8_MMA(1, 0, At, B0); PG8_BAR; PG8_SCHED;
            PG8_STAGE(PG8_SB(1, 1), b3 + hstepB, voffB);
            PG8_WAIT_V(6); PG8_BAR; PG8_MMA(1, 1, At, B1); PG8_BAR;
            }
        }
        if constexpr (ALIGN_EPI) { if (wr == 0) PG8_BAR; }
        if constexpr (!Epi::AFTER_DRAIN) { E(acc, cur, wr, wc, fr, fq); S.done(cur); }
        if (!has_next) break;
#pragma unroll
        for (int a = 0; a < 2; ++a)
#pragma unroll
            for (int b = 0; b < 2; ++b)
#pragma unroll
                for (int m = 0; m < 4; ++m)
#pragma unroll
                    for (int n = 0; n < 2; ++n) acc[a][b][m][n] = (f32x4){0.f, 0.f, 0.f, 0.f};
        cur = nxt; cA = nA; cB = nB; ++ui;
        if constexpr (ALIGN_EPI) { if (wr == 1) PG8_BAR; }
    }
    PG8_WAIT_V(0);
    if constexpr (!ALIGN_EPI) { if (wr == 0) PG8_BAR; }
    PG8_BAR;
    if constexpr (Epi::AFTER_DRAIN) { E.fused(acc, cur, wr, wc, fr, fq, lds, wid, lane); S.done(cur); }
#undef PG8_SA
#undef PG8_SB
#undef PG8_STAGE
#undef PG8_LDA
#undef PG8_LDB
#undef PG8_MMA
#undef PG8_WAIT_V
#undef PG8_WAIT_L
#undef PG8_BAR
#undef PG8_SCHED
}
}
__device__ __forceinline__ void wconv(unsigned char* lds, const float* __restrict__ src, bf16_t* __restrict__ dst, int K, int Nsrc, int Ndst, int mode, int nbatch) {
  float* tile = (float*)lds;
  const int tid = otid();
  const int tk = K >> 6, tn = Ndst >> 6, per = tk * tn, total = per * nbatch;
  for (int it = obid(); it < total; it += gridDim.x) {
    const int bi = it / per, rem = it - bi * per, kt = rem / tn, nt = rem - kt * tn;
    const float* s = src + (size_t)bi * K * Nsrc; bf16_t* d = dst + (size_t)bi * Ndst * K;
    const int nn = tid & 63, dcol = nt * 64 + nn;
    int scol; float scale = 1.f;
    if (mode == 0) scol = dcol < Nsrc ? dcol : -1;
    else {
      if (dcol < 2048) { scol = dcol; if (dcol >= 512 && dcol < 1024) scale = 0.08838834764831845f; }
      else if (dcol < 3072) scol = dcol - 2048 + 3080;
      else if (dcol < 4096) scol = dcol - 3072 + 2048;
      else if (dcol < 5120) scol = dcol - 4096 + 4104;
      else if (dcol < 5128) scol = dcol - 5120 + 3072;
      else scol = -1;
    }
    __syncthreads();
#pragma unroll
    for (int i = 0; i < 8; ++i) {
      const int kk = (tid >> 6) + 8 * i;
      float v = 0.f; if (scol >= 0) v = s[(size_t)(kt * 64 + kk) * Nsrc + scol] * scale;
      tile[kk * 65 + nn] = v;
    }
    __syncthreads();
    {
      const int q = tid, n2 = q >> 3, kc = q & 7;
      float v[8];
#pragma unroll
      for (int j = 0; j < 8; ++j) v[j] = tile[(kc * 8 + j) * 65 + n2];
      uint4 w = make_uint4(pk_bf16(v[0], v[1]), pk_bf16(v[2], v[3]), pk_bf16(v[4], v[5]), pk_bf16(v[6], v[7]));
      *(uint4*)(d + (size_t)(nt * 64 + n2) * K + kt * 64 + kc * 8) = w;
    }
  }
  __syncthreads();
}

__device__ __forceinline__ void norm_phase(const Params& p, const float* __restrict__ gain, int mode, int nslab) {
  const int tid = otid(); const int lane = tid & 63, wave = (obid() * NT + tid) >> 6, nw = gridDim.x * (NT / 64);
  bf16_t* xn = (bf16_t*)(p.ws + OFF_XN);
  auto srcrow = [&](int r) -> const float* {
    if (mode == 1 || (mode == 2 && r >= 32768)) return xrow(p, r);
    return hrow(p, r); };
  float4 v[4], vn[4];
  if (wave < M) { const float* src = srcrow(wave);
#pragma unroll
    for (int i = 0; i < 4; ++i) vn[i] = *(const float4*)(src + i * 256 + lane * 4); }
  for (int r = wave; r < M; r += nw) {
    float* hp = hrow(p, r);
#pragma unroll
    for (int i = 0; i < 4; ++i) v[i] = vn[i];
    if (r + nw < M) { const float* src = srcrow(r + nw);
#pragma unroll
      for (int i = 0; i < 4; ++i) vn[i] = *(const float4*)(src + i * 256 + lane * 4); }
    if (nslab > 0 && r >= 32768) {
      const float* sl = (const float*)(p.ws + OFF_SLAB) + (size_t)(r - 32768) * 1024 + lane * 4;
      for (int sI = 0; sI < nslab; ++sI)
#pragma unroll
        for (int i = 0; i < 4; ++i) { const float4 a = *(const float4*)(sl + (size_t)sI * 131072 + i * 256); v[i].x += a.x; v[i].y += a.y; v[i].z += a.z; v[i].w += a.w; }
#pragma unroll
      for (int i = 0; i < 4; ++i) *(float4*)(hp + i * 256 + lane * 4) = v[i];
    }
    float ss = 0.f;
#pragma unroll
    for (int i = 0; i < 4; ++i) ss += v[i].x * v[i].x + v[i].y * v[i].y + v[i].z * v[i].z + v[i].w * v[i].w;
    ss = wave_sum(ss);
    const float rs = rsqrtf(ss * (1.0f / 1024.0f) + EPS);
#pragma unroll
    for (int i = 0; i < 4; ++i) {
      const float4 g = *(const float4*)(gain + i * 256 + lane * 4);
      uint2 w; w.x = pk_bf16(v[i].x * rs * g.x, v[i].y * rs * g.y); w.y = pk_bf16(v[i].z * rs * g.z, v[i].w * rs * g.w);
      *(uint2*)(xn + (size_t)r * 1024 + i * 256 + lane * 4) = w;
    }
  }
}

__device__ __forceinline__ void mlstm_item(const Params& p, unsigned char* lds, int item, const int tid, unsigned* hcnt, unsigned& hgen) {
  const int w = tid >> 6, lane = tid & 63, fr = lane & 15, fq = lane >> 4;
  const int sl = item & 7, hh = (item >> 3) & 3, b = item >> 5;
  bf16_t* Z = (bf16_t*)(p.ws + OFF_Z);
  const float* GE = (const float*)(p.ws + OFF_GATES);
  bf16_t* Qs = (bf16_t*)lds;
  bf16_t* Ks = Qs + 64 * 136;
  bf16_t* Kt = Ks + 64 * 136;
  bf16_t* Vt = Kt + 128 * 72;
  bf16_t* Ct = Vt + 32 * 72;
  float* fv = (float*)(Ct + 32 * 136);
  float *rowt = fv, *cols = fv + 64, *winter = fv + 128, *emr = fv + 192, *wkv = fv + 256, *denv = fv + 320, *qn = fv + 384, *nv = fv + 448, *scal = fv + 576;
  const float bI = p.ev_b_if[hh], bF = p.ev_b_if[4 + hh];
  f32x4 Cacc[2][2];
#pragma unroll
  for (int i = 0; i < 2; ++i)
#pragma unroll
    for (int j = 0; j < 2; ++j) Cacc[i][j] = (f32x4){0.f, 0.f, 0.f, 0.f};
  float m_state = 0.f;
  HBAR();
  if (tid < 128) nv[tid] = 0.f;
  uint4 rqA[4], rkA[4], rvA, rqB[4], rkB[4], rvB; float giA = 0.f, gfA = 0.f, giB = 0.f, gfB = 0.f;
  auto prefetch = [&](int c, uint4 (&rq)[4], uint4 (&rk)[4], uint4& rv, float& gi, float& gf) {
#pragma unroll
    for (int i = 0; i < 4; ++i) {
      const int tok = 64 * c - 48 + lane;
      if (tok >= 0) { const bf16_t* s = Z + (size_t)(b * T + tok) * LDZE + hh * 128 + (4 * w + i) * 8; rq[i] = *(const uint4*)s; rk[i] = *(const uint4*)(s + 512); }
      else { rq[i] = make_uint4(0, 0, 0, 0); rk[i] = make_uint4(0, 0, 0, 0); }
    }
    { const int tok = 64 * c - 48 + lane;
      if (tok >= 0) rv = *(const uint4*)(Z + (size_t)(b * T + tok) * LDZE + 1024 + hh * 256 + sl * 32 + w * 8); else rv = make_uint4(0, 0, 0, 0); }
    if (w == 0) { const int tok = 64 * c - 48 + lane; if (tok >= 0) { gi = GE[(size_t)(b * T + tok) * 8 + hh]; gf = GE[(size_t)(b * T + tok) * 8 + 4 + hh]; } }
  };
  prefetch(0, rqA, rkA, rvA, giA, gfA); prefetch(1, rqB, rkB, rvB, giB, gfB);
  auto chunk_step = [&](const int c, uint4 (&rq)[4], uint4 (&rk)[4], uint4& rv, float& gi, float& gf) {
    if (w == 0) {
      const bool valid = (c > 0) || (lane >= 48);
      const float lf = valid ? logsigmoidf_(gf + bF) : 0.f;
      const float li = valid ? gi + bI : -INFINITY;
      float bb = lf;
#pragma unroll
      for (int o = 1; o < 64; o <<= 1) { const float t = __shfl_up(bb, o); if (lane >= o) bb += t; }
      const float g = __shfl(bb, 63);
      const float cs = li - bb;
      float pm = cs;
#pragma unroll
      for (int o = 1; o < 64; o <<= 1) { const float t = __shfl_up(pm, o); if (lane >= o) pm = fmaxf(pm, t); }
      const float pmax = __shfl(pm, 63);
      const float inter = bb + m_state, mrow = fmaxf(inter, bb + pm);
      rowt[lane] = bb - mrow; cols[lane] = cs; winter[lane] = __expf(inter - mrow); emr[lane] = __expf(-mrow);
      const float m_new = fmaxf(g + m_state, g + pmax);
      wkv[lane] = __expf(g + cs - m_new);
      if (lane == 0) scal[0] = __expf(g + m_state - m_new);
      m_state = m_new;
    }
#pragma unroll
    for (int i = 0; i < 4; ++i) { *(uint4*)(Qs + lane * 136 + (4 * w + i) * 8) = rq[i]; *(uint4*)(Ks + lane * 136 + (4 * w + i) * 8) = rk[i]; }
    { const unsigned vv[4] = {rv.x, rv.y, rv.z, rv.w};
#pragma unroll
      for (int j = 0; j < 4; ++j) { Vt[(w * 8 + 2 * j) * 72 + lane] = (bf16_t)(vv[j] & 0xffffu); Vt[(w * 8 + 2 * j + 1) * 72 + lane] = (bf16_t)(vv[j] >> 16); } }
#pragma unroll
    for (int dt = 0; dt < 2; ++dt)
#pragma unroll
      for (int et = 0; et < 2; ++et) { uint2 wv; wv.x = pk_bf16(Cacc[dt][et][0], Cacc[dt][et][1]); wv.y = pk_bf16(Cacc[dt][et][2], Cacc[dt][et][3]);
        *(uint2*)(Ct + (16 * et + fr) * 136 + 16 * (2 * w + dt) + 4 * fq) = wv; }
    HBAR();
#pragma unroll
    for (int i = 0; i < 4; ++i) {
      const float wks = wkv[lane];
      const unsigned kk[4] = {rk[i].x, rk[i].y, rk[i].z, rk[i].w};
#pragma unroll
      for (int j = 0; j < 4; ++j) { const unsigned pr = pk_bf16(bf_lo(kk[j]) * wks, bf_hi(kk[j]) * wks);
        Kt[((4 * w + i) * 8 + 2 * j) * 72 + lane] = (bf16_t)(pr & 0xffffu); Kt[((4 * w + i) * 8 + 2 * j + 1) * 72 + lane] = (bf16_t)(pr >> 16); }
    }
    if (c + 2 < 65) prefetch(c + 2, rq, rk, rv, gi, gf);
    f32x4 S[4];
#pragma unroll
    for (int st = 0; st < 4; ++st) S[st] = (f32x4){0.f, 0.f, 0.f, 0.f};
#pragma unroll
    for (int ks = 0; ks < 4; ++ks) {
      const bf16x8 bq = *(const bf16x8*)(Qs + (16 * w + fr) * 136 + 32 * ks + 8 * fq);
#pragma unroll
      for (int st = 0; st < 4; ++st) if (st <= w) { const bf16x8 ak = *(const bf16x8*)(Ks + (16 * st + fr) * 136 + 32 * ks + 8 * fq); S[st] = MFMA(ak, bq, S[st]); }
    }
    const float rt = rowt[16 * w + fr];
    float dsum = 0.f;
#pragma unroll
    for (int st = 0; st < 4; ++st)
#pragma unroll
      for (int r = 0; r < 4; ++r) {
        const int s = 16 * st + 4 * fq + r, t = 16 * w + fr;
        float v = 0.f; if (st <= w && s <= t) v = S[st][r] * __expf(rt + cols[s]);
        S[st][r] = v; dsum += v;
      }
    dsum += __shfl_xor(dsum, 16); dsum += __shfl_xor(dsum, 32);
    if (fq == 0) denv[16 * w + fr] = dsum;
    bf16x8 pa[2];
#pragma unroll
    for (int k2 = 0; k2 < 2; ++k2) { uint2 lo, hi; lo.x = pk_bf16(S[2 * k2][0], S[2 * k2][1]); lo.y = pk_bf16(S[2 * k2][2], S[2 * k2][3]);
      hi.x = pk_bf16(S[2 * k2 + 1][0], S[2 * k2 + 1][1]); hi.y = pk_bf16(S[2 * k2 + 1][2], S[2 * k2 + 1][3]); pa[k2] = mk8(lo, hi); }
    {
      const int t = tid >> 2, part = tid & 3; float s = 0.f;
#pragma unroll
      for (int j = 0; j < 4; ++j) { const uint4 qv = *(const uint4*)(Qs + t * 136 + part * 32 + j * 8); const float* np = nv + part * 32 + j * 8;
        s += bf_lo(qv.x) * np[0] + bf_hi(qv.x) * np[1] + bf_lo(qv.y) * np[2] + bf_hi(qv.y) * np[3] + bf_lo(qv.z) * np[4] + bf_hi(qv.z) * np[5] + bf_lo(qv.w) * np[6] + bf_hi(qv.w) * np[7]; }
      s += __shfl_xor(s, 1); s += __shfl_xor(s, 2);
      if (part == 0) qn[t] = s;
    }
    HBAR();
    f32x4 intra[2], inter[2];
#pragma unroll
    for (int et = 0; et < 2; ++et) { intra[et] = (f32x4){0.f, 0.f, 0.f, 0.f}; inter[et] = (f32x4){0.f, 0.f, 0.f, 0.f}; }
#pragma unroll
    for (int k2 = 0; k2 < 2; ++k2) if (2 * k2 <= w) {
#pragma unroll
      for (int et = 0; et < 2; ++et) {
        const uint2 v0 = *(const uint2*)(Vt + (16 * et + fr) * 72 + 32 * k2 + 4 * fq), v1 = *(const uint2*)(Vt + (16 * et + fr) * 72 + 32 * k2 + 16 + 4 * fq);
        intra[et] = MFMA(pa[k2], mk8(v0, v1), intra[et]);
      }
    }
#pragma unroll
    for (int kd = 0; kd < 4; ++kd) {
      const bf16x8 aq = *(const bf16x8*)(Qs + (16 * w + fr) * 136 + 32 * kd + 8 * fq);
#pragma unroll
      for (int et = 0; et < 2; ++et) { const bf16x8 cb = *(const bf16x8*)(Ct + (16 * et + fr) * 136 + 32 * kd + 8 * fq); inter[et] = MFMA(aq, cb, inter[et]); }
    }
#pragma unroll
    for (int r = 0; r < 4; ++r) {
      const int tl = 16 * w + 4 * fq + r, tok = 64 * c - 48 + tl;
      const float wi = winter[tl], dn = wi * qn[tl] + denv[tl], dd = fmaxf(fabsf(dn), emr[tl]), inv = 1.0f / dd;
      if (tok >= 0) {
#pragma unroll
        for (int et = 0; et < 2; ++et) Z[(size_t)(b * T + tok) * LDZE + 1024 + hh * 256 + sl * 32 + 16 * et + fr] = f2bf((wi * inter[et][r] + intra[et][r]) * inv);
      }
    }
    const float sc = scal[0];
#pragma unroll
    for (int dt = 0; dt < 2; ++dt)
#pragma unroll
      for (int et = 0; et < 2; ++et) {
        f32x4 a = Cacc[dt][et] * sc;
#pragma unroll
        for (int ks = 0; ks < 2; ++ks) { const bf16x8 ak = *(const bf16x8*)(Kt + (16 * (2 * w + dt) + fr) * 72 + 32 * ks + 8 * fq); const bf16x8 vb = *(const bf16x8*)(Vt + (16 * et + fr) * 72 + 32 * ks + 8 * fq); a = MFMA(ak, vb, a); }
        Cacc[dt][et] = a;
      }
    if (tid < 128) { float s = 0.f;
#pragma unroll
      for (int j = 0; j < 8; ++j) { const uint4 kv = *(const uint4*)(Kt + tid * 72 + j * 8); s += bf_lo(kv.x) + bf_hi(kv.x) + bf_lo(kv.y) + bf_hi(kv.y) + bf_lo(kv.z) + bf_hi(kv.z) + bf_lo(kv.w) + bf_hi(kv.w); }
      nv[tid] = sc * nv[tid] + s; }
    HBAR();
  };
  for (int c = 0; c < 65; c += 2) {
    chunk_step(c, rqA, rkA, rvA, giA, gfA);
    if (c + 1 < 65) chunk_step(c + 1, rqB, rkB, rvB, giB, gfB);
  }
}

__device__ __forceinline__ void mlstm_item8(const Params& p, unsigned char* lds, int item) {
  const int tid = otid(), w = __builtin_amdgcn_readfirstlane(tid >> 6), lane = tid & 63, fr = lane & 15, fq = lane >> 4;
  const int s2 = item & 3, hh = (item >> 2) & 3, b = item >> 4;
  bf16_t* Z = (bf16_t*)(p.ws + OFF_Z);
  const float* GE = (const float*)(p.ws + OFF_GATES);
  bf16_t* Qs = (bf16_t*)lds;
  bf16_t* Ks = Qs + 64 * 136;
  bf16_t* Kt = Ks + 64 * 136;
  bf16_t* Vt = Kt + 128 * 72;
  bf16_t* Ct = Vt + 64 * 72;
  bf16_t* Sp = Ct + 64 * 136;
  float* fv = (float*)(Sp + 64 * 72);
  float *rowt = fv, *cols = fv + 64, *winter = fv + 128, *emr = fv + 192, *wkv = fv + 256, *qn = fv + 320, *nv = fv + 384, *scal = fv + 512, *dpart = fv + 576;
  const float bI = p.ev_b_if[hh], bF = p.ev_b_if[4 + hh];
  f32x4 Cacc[4];
#pragma unroll
  for (int j = 0; j < 4; ++j) Cacc[j] = (f32x4){0.f, 0.f, 0.f, 0.f};
  float m_state = 0.f;
  __syncthreads();
  if (tid < 128) nv[tid] = 0.f;
  uint4 rq[2], rk[2], rv; float gi = 0.f, gf = 0.f;
  auto prefetch = [&](int c) {
    const int tok = 64 * c - 48 + lane;
    if (tok >= 0) { const bf16_t* sp = Z + (size_t)(b * T + tok) * LDZE + hh * 128 + (2 * w) * 8; rq[0] = *(const uint4*)sp; rq[1] = *(const uint4*)(sp + 8); rk[0] = *(const uint4*)(sp + 512); rk[1] = *(const uint4*)(sp + 520);
      rv = *(const uint4*)(Z + (size_t)(b * T + tok) * LDZE + 1024 + hh * 256 + s2 * 64 + w * 8); }
    else { rq[0] = rq[1] = rk[0] = rk[1] = rv = make_uint4(0, 0, 0, 0); }
    if (w == 0 && tok >= 0) { gi = GE[(size_t)(b * T + tok) * 8 + hh]; gf = GE[(size_t)(b * T + tok) * 8 + 4 + hh]; }
  };
  prefetch(0);
  for (int c = 0; c < 65; ++c) {
    if (w == 0) {
      const bool valid = (c > 0) || (lane >= 48);
      const float lf = valid ? logsigmoidf_(gf + bF) : 0.f;
      const float li = valid ? gi + bI : -INFINITY;
      float bb = lf;
#pragma unroll
      for (int o = 1; o < 64; o <<= 1) { const float t = __shfl_up(bb, o); if (lane >= o) bb += t; }
      const float g = __shfl(bb, 63);
      const float cs = li - bb;
      float pm = cs;
#pragma unroll
      for (int o = 1; o < 64; o <<= 1) { const float t = __shfl_up(pm, o); if (lane >= o) pm = fmaxf(pm, t); }
      const float pmax = __shfl(pm, 63);
      const float inter = bb + m_state, mrow = fmaxf(inter, bb + pm);
      rowt[lane] = bb - mrow; cols[lane] = cs; winter[lane] = __expf(inter - mrow); emr[lane] = __expf(-mrow);
      const float m_new = fmaxf(g + m_state, g + pmax);
      wkv[lane] = __expf(g + cs - m_new);
      if (lane == 0) scal[0] = __expf(g + m_state - m_new);
      m_state = m_new;
    }
#pragma unroll
    for (int i = 0; i < 2; ++i) { *(uint4*)(Qs + lane * 136 + (2 * w + i) * 8) = rq[i]; *(uint4*)(Ks + lane * 136 + (2 * w + i) * 8) = rk[i]; }
    { const unsigned vv[4] = {rv.x, rv.y, rv.z, rv.w};
#pragma unroll
      for (int j = 0; j < 4; ++j) { Vt[(w * 8 + 2 * j) * 72 + lane] = (bf16_t)(vv[j] & 0xffffu); Vt[(w * 8 + 2 * j + 1) * 72 + lane] = (bf16_t)(vv[j] >> 16); } }
#pragma unroll
    for (int et = 0; et < 4; ++et) { uint2 wv; wv.x = pk_bf16(Cacc[et][0], Cacc[et][1]); wv.y = pk_bf16(Cacc[et][2], Cacc[et][3]);
      *(uint2*)(Ct + (16 * et + fr) * 136 + 16 * w + 4 * fq) = wv; }
    LBAR();
    { const float wks = wkv[lane];
#pragma unroll
      for (int i = 0; i < 2; ++i) { const unsigned kk[4] = {rk[i].x, rk[i].y, rk[i].z, rk[i].w};
#pragma unroll
        for (int j = 0; j < 4; ++j) { const unsigned pr = pk_bf16(bf_lo(kk[j]) * wks, bf_hi(kk[j]) * wks);
          Kt[((2 * w + i) * 8 + 2 * j) * 72 + lane] = (bf16_t)(pr & 0xffffu); Kt[((2 * w + i) * 8 + 2 * j + 1) * 72 + lane] = (bf16_t)(pr >> 16); } } }
    if (c + 1 < 65) prefetch(c + 1);
    auto stile = [&](const int st, const int tt) {
      f32x4 S = (f32x4){0.f, 0.f, 0.f, 0.f};
#pragma unroll
      for (int ks = 0; ks < 4; ++ks) { const bf16x8 ak = *(const bf16x8*)(Ks + (16 * st + fr) * 136 + 32 * ks + 8 * fq); const bf16x8 bq = *(const bf16x8*)(Qs + (16 * tt + fr) * 136 + 32 * ks + 8 * fq); S = MFMA(ak, bq, S); }
      const int t = 16 * tt + fr; const float rt = rowt[t]; float ds = 0.f;
#pragma unroll
      for (int r = 0; r < 4; ++r) { const int sI = 16 * st + 4 * fq + r; float v = 0.f; if (sI <= t) v = S[r] * __expf(rt + cols[sI]); S[r] = v; ds += v; }
      ds += __shfl_xor(ds, 16); ds += __shfl_xor(ds, 32);
      if (fq == 0) dpart[st * 64 + t] = ds;
      uint2 wv; wv.x = pk_bf16(S[0], S[1]); wv.y = pk_bf16(S[2], S[3]);
      *(uint2*)(Sp + t * 72 + 16 * st + 4 * fq) = wv;
    };
    if (w == 0) { stile(0, 0); stile(0, 3); }
    else if (w == 1) { stile(0, 1); stile(1, 3); }
    else if (w == 2) { stile(1, 1); stile(2, 3); }
    else if (w == 3) { stile(0, 2); stile(3, 3); }
    else if (w == 4) { stile(1, 2); }
    else if (w == 5) { stile(2, 2); }
    {
      const int t = tid >> 3, part = tid & 7; float sacc = 0.f;
#pragma unroll
      for (int j = 0; j < 2; ++j) { const uint4 qv = *(const uint4*)(Qs + t * 136 + part * 16 + j * 8); const float* np = nv + part * 16 + j * 8;
        sacc += bf_lo(qv.x) * np[0] + bf_hi(qv.x) * np[1] + bf_lo(qv.y) * np[2] + bf_hi(qv.y) * np[3] + bf_lo(qv.z) * np[4] + bf_hi(qv.z) * np[5] + bf_lo(qv.w) * np[6] + bf_hi(qv.w) * np[7]; }
      sacc += __shfl_xor(sacc, 1); sacc += __shfl_xor(sacc, 2); sacc += __shfl_xor(sacc, 4);
      if (part == 0) qn[t] = sacc;
    }
    LBAR();
    { const int tt = w & 3, eh = w >> 2;
      f32x4 intra[2], inter[2];
#pragma unroll
      for (int e2 = 0; e2 < 2; ++e2) { intra[e2] = (f32x4){0.f, 0.f, 0.f, 0.f}; inter[e2] = (f32x4){0.f, 0.f, 0.f, 0.f}; }
#pragma unroll
      for (int k2 = 0; k2 < 2; ++k2) if (2 * k2 <= tt) {
        const uint2 a0 = *(const uint2*)(Sp + (16 * tt + fr) * 72 + 32 * k2 + 4 * fq);
        uint2 a1 = make_uint2(0u, 0u); if (2 * k2 + 1 <= tt) a1 = *(const uint2*)(Sp + (16 * tt + fr) * 72 + 32 * k2 + 16 + 4 * fq);
        const bf16x8 pa = mk8(a0, a1);
#pragma unroll
        for (int e2 = 0; e2 < 2; ++e2) { const int et = 2 * eh + e2;
          const uint2 v0 = *(const uint2*)(Vt + (16 * et + fr) * 72 + 32 * k2 + 4 * fq), v1 = *(const uint2*)(Vt + (16 * et + fr) * 72 + 32 * k2 + 16 + 4 * fq);
          intra[e2] = MFMA(pa, mk8(v0, v1), intra[e2]); }
      }
#pragma unroll
      for (int kd = 0; kd < 4; ++kd) { const bf16x8 aq = *(const bf16x8*)(Qs + (16 * tt + fr) * 136 + 32 * kd + 8 * fq);
#pragma unroll
        for (int e2 = 0; e2 < 2; ++e2) { const bf16x8 cb = *(const bf16x8*)(Ct + (16 * (2 * eh + e2) + fr) * 136 + 32 * kd + 8 * fq); inter[e2] = MFMA(aq, cb, inter[e2]); } }
#pragma unroll
      for (int r = 0; r < 4; ++r) {
        const int tl = 16 * tt + 4 * fq + r, tok = 64 * c - 48 + tl;
        float dsum = 0.f;
#pragma unroll
        for (int st = 0; st < 4; ++st) if (st <= tt) dsum += dpart[st * 64 + tl];
        const float wi = winter[tl], dn = wi * qn[tl] + dsum, dd = fmaxf(fabsf(dn), emr[tl]), inv = 1.0f / dd;
        if (tok >= 0) {
#pragma unroll
          for (int e2 = 0; e2 < 2; ++e2) Z[(size_t)(b * T + tok) * LDZE + 1024 + hh * 256 + s2 * 64 + 16 * (2 * eh + e2) + fr] = f2bf((wi * inter[e2][r] + intra[e2][r]) * inv);
        }
      }
    }
    { const float sc = scal[0];
#pragma unroll
      for (int et = 0; et < 4; ++et) {
        f32x4 a = Cacc[et] * sc;
#pragma unroll
        for (int ks = 0; ks < 2; ++ks) { const bf16x8 ak = *(const bf16x8*)(Kt + (16 * w + fr) * 72 + 32 * ks + 8 * fq); const bf16x8 vb = *(const bf16x8*)(Vt + (16 * et + fr) * 72 + 32 * ks + 8 * fq); a = MFMA(ak, vb, a); }
        Cacc[et] = a;
      }
      if (tid >= 384) { const int d = tid - 384; float sacc = 0.f;
#pragma unroll
        for (int j = 0; j < 8; ++j) { const uint4 kv = *(const uint4*)(Kt + d * 72 + j * 8); sacc += bf_lo(kv.x) + bf_hi(kv.x) + bf_lo(kv.y) + bf_hi(kv.y) + bf_lo(kv.z) + bf_hi(kv.z) + bf_lo(kv.w) + bf_hi(kv.w); }
        nv[d] = sc * nv[d] + sacc; }
    }
    LBAR();
  }
}

__device__ __forceinline__ void rglru_item(const Params& p, unsigned char* lds, int item, const int tid, unsigned* hcnt, unsigned& hgen) {
  const int w = tid >> 6, lane = tid & 63, fr = lane & 15, fq = lane >> 4;
  const int q4 = item & 3, g = (item >> 2) & 7, b = item >> 5;
  bf16_t* Z = (bf16_t*)(p.ws + OFF_Z);
  bf16_t* raw = (bf16_t*)lds;
  bf16_t* xcA = raw + 67 * 136;
  float* xcF = (float*)(xcA + 64 * 136);
  float* aS = xcF + 2112;
  float* uS = aS + 2112;
  float* cw = uS + 2112;
  float* segP = cw + 640;
  float* segL = segP + 256;
  float* hst = segL + 256;
  HBAR();
  for (int i = tid; i < 640; i += 256) { const int k = i >> 7, c = i & 127; cw[i] = k < 4 ? p.ev_conv_w[k * 1024 + g * 128 + c] : p.ev_conv_b[g * 128 + c]; }
  if (tid < 204) ((unsigned*)raw)[tid] = 0u;
  if (tid < 64) hst[tid] = 0.f;
  const bf16_t* WA = (const bf16_t*)(p.ws + OFF_WRA) + (size_t)g * 16384;
  const bf16_t* WX = (const bf16_t*)(p.ws + OFF_WRX) + (size_t)g * 16384;
  bf16x8 wa[2][4], wx[2][4]; float ba[2], bx[2], sp[2];
#pragma unroll
  for (int nt = 0; nt < 2; ++nt) {
    const int jc = q4 * 32 + 16 * nt + fr, cgi = g * 128 + jc;
#pragma unroll
    for (int kk = 0; kk < 4; ++kk) { wa[nt][kk] = *(const bf16x8*)(WA + jc * 128 + 32 * kk + 8 * fq); wx[nt][kk] = *(const bf16x8*)(WX + jc * 128 + 32 * kk + 8 * fq); }
    ba[nt] = p.ev_b_ra[cgi]; bx[nt] = p.ev_b_rx[cgi]; sp[nt] = log1pf(__expf(-p.ev_lam[cgi]));
  }
  const int prow = tid >> 4, pch = tid & 15;
  uint4 rx[4];
  auto prefetch = [&](int ti) {
#pragma unroll
    for (int i = 0; i < 4; ++i) { const int t = 64 * ti + prow + 16 * i;
      if (t < T) rx[i] = *(const uint4*)(Z + (size_t)(b * T + t) * LDZE + 2048 + g * 128 + pch * 8); else rx[i] = make_uint4(0, 0, 0, 0); }
  };
  prefetch(0);
  int cur = 0;
  for (int ti = 0; ti < 65; ++ti) {
    HBAR();
#pragma unroll
    for (int i = 0; i < 4; ++i) *(uint4*)(raw + (3 + prow + 16 * i) * 136 + pch * 8) = rx[i];
    HBAR();
    {
      const int tr = tid >> 2, cp = tid & 3;
#pragma unroll
      for (int c8 = 0; c8 < 4; ++c8) {
        const int c0 = cp * 32 + c8 * 8; float o[8];
#pragma unroll
        for (int j = 0; j < 8; ++j) o[j] = cw[512 + c0 + j];
#pragma unroll
        for (int k = 0; k < 4; ++k) { const uint4 xv = *(const uint4*)(raw + (tr + k) * 136 + c0); const float* wp = cw + k * 128 + c0;
          o[0] += wp[0] * bf_lo(xv.x); o[1] += wp[1] * bf_hi(xv.x); o[2] += wp[2] * bf_lo(xv.y); o[3] += wp[3] * bf_hi(xv.y);
          o[4] += wp[4] * bf_lo(xv.z); o[5] += wp[5] * bf_hi(xv.z); o[6] += wp[6] * bf_lo(xv.w); o[7] += wp[7] * bf_hi(xv.w); }
        *(uint4*)(xcA + tr * 136 + c0) = make_uint4(pk_bf16(o[0], o[1]), pk_bf16(o[2], o[3]), pk_bf16(o[4], o[5]), pk_bf16(o[6], o[7]));
        if (cp == q4) {
#pragma unroll
          for (int j = 0; j < 8; ++j) xcF[tr * 33 + c8 * 8 + j] = o[j]; }
      }
    }
    HBAR();
    if (tid < 192) ((unsigned*)raw)[(tid >> 6) * 68 + (tid & 63)] = ((unsigned*)raw)[(64 + (tid >> 6)) * 68 + (tid & 63)];
    if (ti + 1 < 65) prefetch(ti + 1);
    bf16_t gbv[8];
    { const int j = tid & 31, seg = tid >> 5;
#pragma unroll
      for (int k = 0; k < 8; ++k) { const int t = 64 * ti + 8 * seg + k; gbv[k] = t < T ? Z[(size_t)(b * T + t) * LDZE + 4096 + g * 128 + q4 * 32 + j] : (bf16_t)0; } }
    {
      f32x4 R[2], I[2];
#pragma unroll
      for (int nt = 0; nt < 2; ++nt) { R[nt] = (f32x4){0.f, 0.f, 0.f, 0.f}; I[nt] = (f32x4){0.f, 0.f, 0.f, 0.f}; }
#pragma unroll
      for (int kk = 0; kk < 4; ++kk) { const bf16x8 ax = *(const bf16x8*)(xcA + (16 * w + fr) * 136 + 32 * kk + 8 * fq);
#pragma unroll
        for (int nt = 0; nt < 2; ++nt) { R[nt] = MFMA(ax, wa[nt][kk], R[nt]); I[nt] = MFMA(ax, wx[nt][kk], I[nt]); } }
#pragma unroll
      for (int nt = 0; nt < 2; ++nt)
#pragma unroll
        for (int r = 0; r < 4; ++r) {
          const int t = 16 * w + 4 * fq + r, jl = 16 * nt + fr;
          const float rg = sigmoidf_(R[nt][r] + ba[nt]), ig = sigmoidf_(I[nt][r] + bx[nt]);
          const float la = -8.0f * rg * sp[nt];
          aS[t * 33 + jl] = __builtin_amdgcn_exp2f(la * LOG2E);
          const float x2 = 2.0f * la, om = x2 > -0.25f ? neg_expm1_small(x2) : 1.0f - __builtin_amdgcn_exp2f(x2 * LOG2E);
          uS[t * 33 + jl] = __builtin_amdgcn_sqrtf(om) * (ig * xcF[t * 33 + jl]);
        }
    }
    HBAR();
    const int j = tid & 31, seg = tid >> 5;
    float Lk[8], Pk[8];
    { float P = 1.f, L = 0.f;
#pragma unroll
      for (int k = 0; k < 8; ++k) { const float a = aS[(8 * seg + k) * 33 + j], u = uS[(8 * seg + k) * 33 + j]; L = a * L + u; P = a * P; Lk[k] = L; Pk[k] = P; }
      segP[seg * 32 + j] = P; segL[seg * 32 + j] = L; }
    HBAR();
    { float hin = hst[cur * 32 + j];
#pragma unroll
      for (int s = 0; s < 7; ++s) if (s < seg) hin = segP[s * 32 + j] * hin + segL[s * 32 + j];
#pragma unroll
      for (int k = 0; k < 8; ++k) {
        const float hv = Lk[k] + Pk[k] * hin; const int t = 64 * ti + 8 * seg + k;
        if (k == 7 && seg == 7) hst[(cur ^ 1) * 32 + j] = hv;
        if (t < T) { bf16_t* gp = Z + (size_t)(b * T + t) * LDZE + 4096 + g * 128 + q4 * 32 + j; const float x = bf2f(gbv[k]);
          const float ge = x * sigmoidf_(1.5957691216057308f * (x + 0.044715f * x * x * x)); *gp = f2bf(hv * ge); }
      }
    }
    cur ^= 1;
  }
}

__device__ __forceinline__ void rglru_item8(const Params& p, unsigned char* lds, int item) {
  const int tid = otid(), w = __builtin_amdgcn_readfirstlane(tid >> 6), lane = tid & 63, fr = lane & 15, fq = lane >> 4;
  const int h2 = item & 1, g = (item >> 1) & 7, b = item >> 4;
  bf16_t* Z = (bf16_t*)(p.ws + OFF_Z);
  bf16_t* raw = (bf16_t*)lds;
  bf16_t* xcA = raw + 67 * 136;
  float* xcF = (float*)(xcA + 64 * 136);
  float* aS = xcF + 64 * 65;
  float* uS = aS + 64 * 65;
  float* cw = uS + 64 * 65;
  float* segP = cw + 640;
  float* segL = segP + 512;
  float* hst = segL + 512;
  LBAR();
  for (int i = tid; i < 640; i += NT) { const int k = i >> 7, c = i & 127; cw[i] = k < 4 ? p.ev_conv_w[k * 1024 + g * 128 + c] : p.ev_conv_b[g * 128 + c]; }
  if (tid < 204) ((unsigned*)raw)[tid] = 0u;
  if (tid < 128) hst[tid] = 0.f;
  const int tt = w & 3, jh = w >> 2;
  const bf16_t* WA = (const bf16_t*)(p.ws + OFF_WRA) + (size_t)g * 16384;
  const bf16_t* WX = (const bf16_t*)(p.ws + OFF_WRX) + (size_t)g * 16384;
  bf16x8 wa[2][4], wx[2][4]; float ba[2], bx[2], sp[2];
#pragma unroll
  for (int nt = 0; nt < 2; ++nt) {
    const int jc = h2 * 64 + jh * 32 + 16 * nt + fr, cgi = g * 128 + jc;
#pragma unroll
    for (int kk = 0; kk < 4; ++kk) { wa[nt][kk] = *(const bf16x8*)(WA + jc * 128 + 32 * kk + 8 * fq); wx[nt][kk] = *(const bf16x8*)(WX + jc * 128 + 32 * kk + 8 * fq); }
    ba[nt] = p.ev_b_ra[cgi]; bx[nt] = p.ev_b_rx[cgi]; sp[nt] = log1pf(__expf(-p.ev_lam[cgi]));
  }
  const int prow = tid >> 4, pch = tid & 15;
  uint4 rx[2];
  auto prefetch = [&](int ti) {
#pragma unroll
    for (int i = 0; i < 2; ++i) { const int t = 64 * ti + prow + 32 * i;
      if (t < T) rx[i] = *(const uint4*)(Z + (size_t)(b * T + t) * LDZE + 2048 + g * 128 + pch * 8); else rx[i] = make_uint4(0, 0, 0, 0); }
  };
  prefetch(0);
  int cur = 0;
  for (int ti = 0; ti < 65; ++ti) {
    LBAR();
#pragma unroll
    for (int i = 0; i < 2; ++i) *(uint4*)(raw + (3 + prow + 32 * i) * 136 + pch * 8) = rx[i];
    LBAR();
    {
      const int tr = tid >> 3, cp = tid & 7;
#pragma unroll
      for (int c8 = 0; c8 < 2; ++c8) {
        const int c0 = cp * 16 + c8 * 8; float o[8];
#pragma unroll
        for (int j = 0; j < 8; ++j) o[j] = cw[512 + c0 + j];
#pragma unroll
        for (int k = 0; k < 4; ++k) { const uint4 xv = *(const uint4*)(raw + (tr + k) * 136 + c0); const float* wp = cw + k * 128 + c0;
          o[0] += wp[0] * bf_lo(xv.x); o[1] += wp[1] * bf_hi(xv.x); o[2] += wp[2] * bf_lo(xv.y); o[3] += wp[3] * bf_hi(xv.y);
          o[4] += wp[4] * bf_lo(xv.z); o[5] += wp[5] * bf_hi(xv.z); o[6] += wp[6] * bf_lo(xv.w); o[7] += wp[7] * bf_hi(xv.w); }
        *(uint4*)(xcA + tr * 136 + c0) = make_uint4(pk_bf16(o[0], o[1]), pk_bf16(o[2], o[3]), pk_bf16(o[4], o[5]), pk_bf16(o[6], o[7]));
        if ((cp >> 2) == h2) {
#pragma unroll
          for (int j = 0; j < 8; ++j) xcF[tr * 65 + (c0 - 64 * h2) + j] = o[j]; }
      }
    }
    LBAR();
    if (tid < 192) ((unsigned*)raw)[(tid >> 6) * 68 + (tid & 63)] = ((unsigned*)raw)[(64 + (tid >> 6)) * 68 + (tid & 63)];
    if (ti + 1 < 65) prefetch(ti + 1);
    bf16_t gbv[8];
#pragma unroll
    for (int k = 0; k < 8; ++k) { const int t = 64 * ti + 8 * w + k; gbv[k] = t < T ? Z[(size_t)(b * T + t) * LDZE + 4096 + g * 128 + h2 * 64 + lane] : (bf16_t)0; }
    {
      f32x4 R[2], I[2];
#pragma unroll
      for (int nt = 0; nt < 2; ++nt) { R[nt] = (f32x4){0.f, 0.f, 0.f, 0.f}; I[nt] = (f32x4){0.f, 0.f, 0.f, 0.f}; }
#pragma unroll
      for (int kk = 0; kk < 4; ++kk) { const bf16x8 ax = *(const bf16x8*)(xcA + (16 * tt + fr) * 136 + 32 * kk + 8 * fq);
#pragma unroll
        for (int nt = 0; nt < 2; ++nt) { R[nt] = MFMA(ax, wa[nt][kk], R[nt]); I[nt] = MFMA(ax, wx[nt][kk], I[nt]); } }
#pragma unroll
      for (int nt = 0; nt < 2; ++nt)
#pragma unroll
        for (int r = 0; r < 4; ++r) {
          const int t = 16 * tt + 4 * fq + r, jl = jh * 32 + 16 * nt + fr;
          const float rg = sigmoidf_(R[nt][r] + ba[nt]), ig = sigmoidf_(I[nt][r] + bx[nt]);
          const float la = -8.0f * rg * sp[nt];
          aS[t * 65 + jl] = __builtin_amdgcn_exp2f(la * LOG2E);
          const float x2 = 2.0f * la, om = x2 > -0.25f ? neg_expm1_small(x2) : 1.0f - __builtin_amdgcn_exp2f(x2 * LOG2E);
          uS[t * 65 + jl] = __builtin_amdgcn_sqrtf(om) * (ig * xcF[t * 65 + jl]);
        }
    }
    LBAR();
    const int j = lane, seg = w;
    float Lk[8], Pk[8];
    { float P = 1.f, L = 0.f;
#pragma unroll
      for (int k = 0; k < 8; ++k) { const float a = aS[(8 * seg + k) * 65 + j], u = uS[(8 * seg + k) * 65 + j]; L = a * L + u; P = a * P; Lk[k] = L; Pk[k] = P; }
      segP[seg * 64 + j] = P; segL[seg * 64 + j] = L; }
    LBAR();
    { float hin = hst[cur * 64 + j];
#pragma unroll
      for (int sI = 0; sI < 7; ++sI) if (sI < seg) hin = segP[sI * 64 + j] * hin + segL[sI * 64 + j];
#pragma unroll
      for (int k = 0; k < 8; ++k) {
        const float hv = Lk[k] + Pk[k] * hin; const int t = 64 * ti + 8 * seg + k;
        if (k == 7 && seg == 7) hst[(cur ^ 1) * 64 + j] = hv;
        if (t < T) { bf16_t* gp = Z + (size_t)(b * T + t) * LDZE + 4096 + g * 128 + h2 * 64 + j; const float x = bf2f(gbv[k]);
          const float ge = x * sigmoidf_(1.5957691216057308f * (x + 0.044715f * x * x * x)); *gp = f2bf(hv * ge); }
      }
    }
    cur ^= 1;
  }
}

__device__ __forceinline__ void anorm_phase(const Params& p) {
  const int tid = otid(); const int lane = tid & 63, wave = (obid() * NT + tid) >> 6, nw = gridDim.x * (NT / 64);
  bf16_t* Z = (bf16_t*)(p.ws + OFF_Z);
  for (int r = wave; r < M; r += nw) {
    bf16_t* zr = Z + (size_t)r * LDZE;
    const uint4 h0 = *(const uint4*)(zr + 1024 + 16 * lane), h1 = *(const uint4*)(zr + 1024 + 16 * lane + 8);
    const uint4 o0 = *(const uint4*)(zr + 3072 + 16 * lane), o1 = *(const uint4*)(zr + 3072 + 16 * lane + 8);
    const unsigned hu[8] = {h0.x, h0.y, h0.z, h0.w, h1.x, h1.y, h1.z, h1.w}, ou[8] = {o0.x, o0.y, o0.z, o0.w, o1.x, o1.y, o1.z, o1.w};
    float hv[16], ov[16]; float ss = 0.f;
#pragma unroll
    for (int i = 0; i < 8; ++i) { hv[2 * i] = bf_lo(hu[i]); hv[2 * i + 1] = bf_hi(hu[i]); ov[2 * i] = bf_lo(ou[i]); ov[2 * i + 1] = bf_hi(ou[i]); ss += hv[2 * i] * hv[2 * i] + hv[2 * i + 1] * hv[2 * i + 1]; }
    ss += __shfl_xor(ss, 1); ss += __shfl_xor(ss, 2); ss += __shfl_xor(ss, 4); ss += __shfl_xor(ss, 8);
    const float rs = rsqrtf(ss * (1.0f / 256.0f) + EPS);
    const float* gp = p.ev_a_norm + ((16 * lane) & 255);
    unsigned res[8];
#pragma unroll
    for (int i = 0; i < 8; ++i) res[i] = pk_bf16(hv[2 * i] * rs * gp[2 * i] * sigmoidf_(ov[2 * i]), hv[2 * i + 1] * rs * gp[2 * i + 1] * sigmoidf_(ov[2 * i + 1]));
    *(uint4*)(zr + 3072 + 16 * lane) = make_uint4(res[0], res[1], res[2], res[3]);
    *(uint4*)(zr + 3072 + 16 * lane + 8) = make_uint4(res[4], res[5], res[6], res[7]);
  }
}

__device__ __forceinline__ void oddprep_phase(const Params& p) {
  const int tid = otid(); const int lane = tid & 63, wave = (obid() * NT + tid) >> 6, nw = gridDim.x * (NT / 64);
  bf16_t* Zo = (bf16_t*)(p.ws + OFF_Z);
  float* G = (float*)(p.ws + OFF_GATES);
  bf16_t* KR = (bf16_t*)(p.ws + OFF_KR);
  float* ROPE = (float*)(p.ws + OFF_ROPE);
  for (int r = wave; r < M; r += nw) {
    bf16_t* zr = Zo + (size_t)r * LDZO;
    {
      unsigned u[3]; float ss = 0.f;
#pragma unroll
      for (int j = 0; j < 3; ++j) { u[j] = *(const unsigned*)(zr + 128 * j + 2 * lane); ss += bf_lo(u[j]) * bf_lo(u[j]) + bf_hi(u[j]) * bf_hi(u[j]); }
      ss = wave_sum(ss); const float rs = rsqrtf(ss * (1.0f / 384.0f) + EPS);
#pragma unroll
      for (int j = 0; j < 3; ++j) { const float* gp = p.od_g_qa + 128 * j + 2 * lane; *(unsigned*)(zr + 128 * j + 2 * lane) = pk_bf16(bf_lo(u[j]) * rs * gp[0], bf_hi(u[j]) * rs * gp[1]); }
    }
    {
      const uint2 u = *(const uint2*)(zr + 384 + 4 * lane);
      float v0 = bf_lo(u.x), v1 = bf_hi(u.x), v2 = bf_lo(u.y), v3 = bf_hi(u.y);
      float ss = wave_sum(v0 * v0 + v1 * v1 + v2 * v2 + v3 * v3); const float rs = rsqrtf(ss * (1.0f / 256.0f) + EPS);
      const float* gp = p.od_g_kva + 4 * lane; uint2 o; o.x = pk_bf16(v0 * rs * gp[0], v1 * rs * gp[1]); o.y = pk_bf16(v2 * rs * gp[2], v3 * rs * gp[3]);
      *(uint2*)(zr + 384 + 4 * lane) = o;
    }
    {
      const int b = r / T, t = r - b * T;
      const int pos = t < 16 ? t : p.pos[b * 4096 + (t - 16)] + 16;
      const int i = lane & 15;
      const float freq = exp2f(-(float)i * 0.8304820237218406f);
      const float ang = (float)pos * freq;
      double rev = (double)ang * 0.15915494309189535; rev -= rint(rev);
      const float rf = (float)rev;
      const float cs = __builtin_amdgcn_cosf(rf), sn = __builtin_amdgcn_sinf(rf);
      float v = lane < 32 ? bf2f(zr[640 + lane]) : 0.f;
      const float ss = wave_sum(v * v); const float rs = rsqrtf(ss * (1.0f / 32.0f) + EPS);
      const float kn = lane < 32 ? v * rs * p.od_g_kr[lane & 31] : 0.f;
      const float pt = __shfl_xor(kn, 16);
      const float o = lane < 16 ? kn * cs - pt * sn : pt * sn + kn * cs;
      if (lane < 32) KR[(size_t)r * 32 + lane] = f2bf(o);
      if (lane < 16) { ROPE[(size_t)r * 32 + lane] = cs; ROPE[(size_t)r * 32 + 16 + lane] = sn; }
    }
#pragma unroll
    for (int which = 0; which < 2; ++which) {
      bf16_t* base = zr + (which ? 1184 : 672) + 8 * lane; const float* gg = (which ? p.od_g_fk : p.od_g_fq) + 8 * (lane & 7);
      const uint4 u = *(const uint4*)base; const unsigned uu[4] = {u.x, u.y, u.z, u.w};
      float v[8]; float ss = 0.f;
#pragma unroll
      for (int j = 0; j < 4; ++j) { v[2 * j] = bf_lo(uu[j]); v[2 * j + 1] = bf_hi(uu[j]); ss += v[2 * j] * v[2 * j] + v[2 * j + 1] * v[2 * j + 1]; }
      ss += __shfl_xor(ss, 1); ss += __shfl_xor(ss, 2); ss += __shfl_xor(ss, 4);
      const float rs = rsqrtf(ss * (1.0f / 64.0f) + EPS);
      *(uint4*)base = make_uint4(pk_bf16(v[0] * rs * gg[0], v[1] * rs * gg[1]), pk_bf16(v[2] * rs * gg[2], v[3] * rs * gg[3]), pk_bf16(v[4] * rs * gg[4], v[5] * rs * gg[5]), pk_bf16(v[6] * rs * gg[6], v[7] * rs * gg[7]));
    }
    if (lane < 8) { float* gp = G + (size_t)r * 8 + lane; *gp = logsigmoidf_(*gp + p.od_b_f[lane]); }
  }
}

__device__ __forceinline__ void fcum_item(const Params& p, unsigned char* lds, int item) {
  const int tid = otid(), b = item >> 3, hh = item & 7;
  const float* G = (const float*)(p.ws + OFF_GATES);
  float* FC = (float*)(p.ws + OFF_FCUM) + (size_t)item * T;
  float* part = (float*)lds;
  float loc[9]; float s = 0.f;
#pragma unroll
  for (int k = 0; k < 9; ++k) { const int t = tid * 9 + k; loc[k] = t < T ? G[(size_t)(b * T + t) * 8 + hh] : 0.f; s += loc[k]; }
  __syncthreads();
  part[tid] = s;
  __syncthreads();
  float pre = 0.f;
  for (int i = 0; i < tid; ++i) pre += part[i];
#pragma unroll
  for (int k = 0; k < 9; ++k) { const int t = tid * 9 + k; pre += loc[k]; if (t < T) FC[t] = pre; }
  __syncthreads();
}

__device__ __forceinline__ void headprep_phase(const Params& p) {
  bf16_t* QR = (bf16_t*)(p.ws + OFF_QRAW); bf16_t* KV = (bf16_t*)(p.ws + OFF_KVRAW);
  const float* ROPE = (const float*)(p.ws + OFF_ROPE);
  const int gt = obid() * NT + otid(), nth = gridDim.x * NT;
  for (int idx = gt; idx < M * 8; idx += nth) {
    const int r = idx >> 3, hh = idx & 7;
    { bf16_t* qp = QR + (size_t)r * 768 + hh * 96;
      float v[96]; float s1 = 0.f, s2 = 0.f;
#pragma unroll
      for (int c = 0; c < 12; ++c) { const uint4 u = *(const uint4*)(qp + 8 * c); const unsigned uu[4] = {u.x, u.y, u.z, u.w};
#pragma unroll
        for (int j = 0; j < 4; ++j) { v[8 * c + 2 * j] = bf_lo(uu[j]); v[8 * c + 2 * j + 1] = bf_hi(uu[j]); } }
#pragma unroll
      for (int i = 0; i < 64; ++i) s1 += v[i] * v[i];
#pragma unroll
      for (int i = 64; i < 96; ++i) s2 += v[i] * v[i];
      const float r1 = rsqrtf(s1 * (1.0f / 64.0f) + EPS), r2 = rsqrtf(s2 * (1.0f / 32.0f) + EPS);
#pragma unroll
      for (int i = 0; i < 64; ++i) v[i] = v[i] * r1 * p.od_g_qn[i];
#pragma unroll
      for (int i = 0; i < 32; ++i) v[64 + i] = v[64 + i] * r2 * p.od_g_qr[i];
#pragma unroll
      for (int i = 0; i < 16; ++i) { const float cs = ROPE[(size_t)r * 32 + i], sn = ROPE[(size_t)r * 32 + 16 + i]; const float x1 = v[64 + i], x2 = v[80 + i]; v[64 + i] = x1 * cs - x2 * sn; v[80 + i] = x1 * sn + x2 * cs; }
#pragma unroll
      for (int c = 0; c < 12; ++c) *(uint4*)(qp + 8 * c) = make_uint4(pk_bf16(v[8 * c], v[8 * c + 1]), pk_bf16(v[8 * c + 2], v[8 * c + 3]), pk_bf16(v[8 * c + 4], v[8 * c + 5]), pk_bf16(v[8 * c + 6], v[8 * c + 7]));
    }
    { bf16_t* kp = KV + (size_t)r * 1024 + hh * 128;
      float v[64]; float s1 = 0.f;
#pragma unroll
      for (int c = 0; c < 8; ++c) { const uint4 u = *(const uint4*)(kp + 8 * c); const unsigned uu[4] = {u.x, u.y, u.z, u.w};
#pragma unroll
        for (int j = 0; j < 4; ++j) { v[8 * c + 2 * j] = bf_lo(uu[j]); v[8 * c + 2 * j + 1] = bf_hi(uu[j]); } }
#pragma unroll
      for (int i = 0; i < 64; ++i) s1 += v[i] * v[i];
      const float r1 = rsqrtf(s1 * (1.0f / 64.0f) + EPS);
#pragma unroll
      for (int i = 0; i < 64; ++i) v[i] = v[i] * r1 * p.od_g_kn[i];
#pragma unroll
      for (int c = 0; c < 8; ++c) *(uint4*)(kp + 8 * c) = make_uint4(pk_bf16(v[8 * c], v[8 * c + 1]), pk_bf16(v[8 * c + 2], v[8 * c + 3]), pk_bf16(v[8 * c + 4], v[8 * c + 5]), pk_bf16(v[8 * c + 6], v[8 * c + 7]));
    }
  }
}

#define XB_TMO      128
#define XB_XCNT(j)  (256  + 64 * (j))
#define XB_XSUB(j)  (1280 + 64 * (j))
#define XB_XGEN(j)  (2304 + 64 * (j))
#define XB_TOP      3328
#define XB_TOPGEN   3392
#define XCD_BAR_WORDS 3456
#define XB_SPIN_CAP (1u << 18)
#define LAS __attribute__((address_space(3)))

__device__ __forceinline__ unsigned xb_ld(unsigned* p)              { return __hip_atomic_load(p, __ATOMIC_RELAXED, __HIP_MEMORY_SCOPE_AGENT); }
__device__ __forceinline__ unsigned xb_add(unsigned* p, unsigned v) { return __hip_atomic_fetch_add(p, v, __ATOMIC_RELAXED, __HIP_MEMORY_SCOPE_AGENT); }
__device__ __forceinline__ unsigned xb_xcc_id() { return (unsigned)__builtin_amdgcn_s_getreg((3 << 11) | 20) & 0xFu; }
#define XB_SPIN(cond, bar) do { unsigned _sp = 0; while (cond) { __builtin_amdgcn_s_sleep(1); \
    if ((++_sp & 255u) == 0u) { if (xb_ld(&(bar)[XB_TMO])) break; if (_sp > XB_SPIN_CAP) { atomicAdd(&(bar)[XB_TMO], 1u); break; } } } } while (0)

struct XcdBarrier {
    unsigned* bar; unsigned x;
    volatile LAS unsigned* st;
};

__device__ __forceinline__ XcdBarrier xcd_barrier_post(unsigned* bar, volatile LAS unsigned* st) {
    XcdBarrier b; b.bar = bar; b.x = xb_xcc_id(); b.st = st;
    if (threadIdx.x == 0) (void)xb_add(&bar[XB_XCNT(b.x)], 1u);
    return b;
}
__device__ __forceinline__ void xcd_barrier_complete(unsigned* bar, unsigned x, unsigned& nloc, unsigned& nx) {
    const unsigned G = gridDim.x * gridDim.y * gridDim.z;
    unsigned sum, cnt, mine, sp = 0u;
    for (;;) {
        sum = 0u; cnt = 0u; mine = 0u;
#pragma unroll
        for (unsigned j = 0; j < 16; ++j) { const unsigned c = xb_ld(&bar[XB_XCNT(j)]); sum += c; cnt += (c > 0u) ? 1u : 0u; mine = (j == x) ? c : mine; }
        if (sum == G) break;
        __builtin_amdgcn_s_sleep(1);
        if ((++sp & 255u) == 0u) { if (xb_ld(&bar[XB_TMO])) break; if (sp > XB_SPIN_CAP) { atomicAdd(&bar[XB_TMO], 1u); break; } }
    }
    nloc = mine > 0u ? mine : 1u; nx = cnt > 0u ? cnt : 1u;
}

__device__ __forceinline__ void xcd_barrier(const XcdBarrier& b) {
    asm volatile("s_waitcnt vmcnt(0)" ::: "memory");
    __syncthreads();
    if (threadIdx.x == 0) {
        unsigned* bar = b.bar;
        __builtin_amdgcn_s_waitcnt(0);
        unsigned nloc = b.st[0], nx = b.st[1];
        if (nloc == 0u) { xcd_barrier_complete(bar, b.x, nloc, nx); b.st[0] = nloc; b.st[1] = nx; }
        const unsigned old = xb_add(&bar[XB_XSUB(b.x)], 1u);
        const unsigned gen = old / nloc;
        if (old + 1u == (gen + 1u) * nloc) {
            __builtin_amdgcn_fence(__ATOMIC_RELEASE, "agent");
            asm volatile("s_waitcnt vmcnt(0)" ::: "memory");
            const unsigned og = xb_add(&bar[XB_TOP], 1u);
            const unsigned tg = og / nx;
            if (og + 1u == (tg + 1u) * nx) xb_add(&bar[XB_TOPGEN], 1u);
            else XB_SPIN(xb_ld(&bar[XB_TOPGEN]) == tg, bar);
            __builtin_amdgcn_fence(__ATOMIC_ACQUIRE, "agent");
            xb_add(&bar[XB_XGEN(b.x)], 1u);
            asm volatile("s_waitcnt vmcnt(0)" ::: "memory");
        } else {
            XB_SPIN(xb_ld(&bar[XB_XGEN(b.x)]) == gen, bar);
            __builtin_amdgcn_fence(__ATOMIC_ACQUIRE, "agent");
            asm volatile("s_waitcnt vmcnt(0)" ::: "memory");
        }
    }
    __syncthreads();
}

template <int DK, bool BIAS>
__device__ __forceinline__ void attn_item(unsigned char* lds, const bf16_t* __restrict__ Qp, int ldq, const bf16_t* __restrict__ Kp, int ldk, const bf16_t* __restrict__ K2p, int ldk2,
                          const bf16_t* __restrict__ Vp, int ldv, const float* __restrict__ fc, bf16_t* __restrict__ Op, int b, int q0, int qend, int nkv, float scale) {
  constexpr int KS = DK / 32, KST = DK + 8, NCH = DK / 8, NPIECE = 64 * NCH;
  const int tid = otid(), w = tid >> 6, lane = tid & 63, fr = lane & 15, fq = lane >> 4;
  bf16_t* Ksm = (bf16_t*)lds;
  bf16_t* Vtm = Ksm + 2 * 64 * KST;
  float* fkm = (float*)(Vtm + 2 * 64 * 72);
  const int rowb = b * T;
  const bool wact = q0 + 32 * w < qend;
  bf16x8 qf[2][KS];
#pragma unroll
  for (int qi = 0; qi < 2; ++qi) {
    const int qg = q0 + 32 * w + 16 * qi + fr;
#pragma unroll
    for (int ks = 0; ks < KS; ++ks) { uint4 u = make_uint4(0, 0, 0, 0); if (qg < qend) u = *(const uint4*)(Qp + (size_t)(rowb + qg) * ldq + 32 * ks + 8 * fq); qf[qi][ks] = mk8u(u); }
  }
  f32x4 O[4][2];
#pragma unroll
  for (int et = 0; et < 4; ++et)
#pragma unroll
    for (int qi = 0; qi < 2; ++qi) O[et][qi] = (f32x4){0.f, 0.f, 0.f, 0.f};
  float mrun[2] = {-1e30f, -1e30f}, lrun[2] = {0.f, 0.f};
  uint4 rk0A, rk1A = make_uint4(0, 0, 0, 0), rvA, rk0B = make_uint4(0, 0, 0, 0), rk1B = make_uint4(0, 0, 0, 0), rvB = make_uint4(0, 0, 0, 0); float rfkA = 0.f, rfkB = 0.f;
  const int krow0 = tid / NCH, kch0 = tid - krow0 * NCH, krow1 = (tid + 512) / NCH, kch1 = (tid + 512) - krow1 * NCH;
  const int vrow = tid & 63, vch = tid >> 6;
  auto kload = [&](int kg, int chn) -> uint4 {
    uint4 u = make_uint4(0, 0, 0, 0);
    if (kg < T) { if (DK == 64 || chn < 8) u = *(const uint4*)(Kp + (size_t)(rowb + kg) * ldk + chn * 8); else u = *(const uint4*)(K2p + (size_t)(rowb + kg) * ldk2 + (chn - 8) * 8); }
    return u; };
  auto prefetch = [&](int j, uint4& rk0, uint4& rk1, uint4& rv, float& rfk) {
    rk0 = kload(64 * j + krow0, kch0);
    if (NPIECE > 512 && tid + 512 < NPIECE) rk1 = kload(64 * j + krow1, kch1);
    { const int kg = 64 * j + vrow; rv = make_uint4(0, 0, 0, 0); if (kg < T) rv = *(const uint4*)(Vp + (size_t)(rowb + kg) * ldv + vch * 8); }
    if (BIAS && tid < 64) { const int kg = 64 * j + tid; rfk = kg < T ? -fc[kg] * LOG2E : 0.f; }
  };
  auto stage = [&](int buf, const uint4& rk0, const uint4& rk1, const uint4& rv, const float& rfk) {
    *(uint4*)(Ksm + (buf * 64 + krow0) * KST + kch0 * 8) = rk0;
    if (NPIECE > 512 && tid + 512 < NPIECE) *(uint4*)(Ksm + (buf * 64 + krow1) * KST + kch1 * 8) = rk1;
    { const unsigned vv[4] = {rv.x, rv.y, rv.z, rv.w};
#pragma unroll
      for (int jj = 0; jj < 4; ++jj) { Vtm[(buf * 64 + vch * 8 + 2 * jj) * 72 + vrow] = (bf16_t)(vv[jj] & 0xffffu); Vtm[(buf * 64 + vch * 8 + 2 * jj + 1) * 72 + vrow] = (bf16_t)(vv[jj] >> 16); } }
    if (BIAS && tid < 64) fkm[buf * 64 + tid] = rfk;
  };
  __syncthreads();
  prefetch(0, rk0A, rk1A, rvA, rfkA); stage(0, rk0A, rk1A, rvA, rfkA);
  if (nkv > 1) prefetch(1, rk0B, rk1B, rvB, rfkB);
  __syncthreads();
  const float sc2 = scale * LOG2E;
  auto tile_step = [&](const int j, uint4& pk0, uint4& pk1, uint4& pv, float& pfk, const uint4& sk0, const uint4& sk1, const uint4& sv, const float& sfk) {
    const int buf = j & 1;
    if (j + 2 < nkv) prefetch(j + 2, pk0, pk1, pv, pfk);
    if (wact && 64 * j <= q0 + 32 * w + 31) {
      f32x4 S[4][2];
#pragma unroll
      for (int kt = 0; kt < 4; ++kt)
#pragma unroll
        for (int qi = 0; qi < 2; ++qi) S[kt][qi] = (f32x4){0.f, 0.f, 0.f, 0.f};
#pragma unroll
      for (int ks = 0; ks < KS; ++ks)
#pragma unroll
        for (int kt = 0; kt < 4; ++kt) { const bf16x8 ak = *(const bf16x8*)(Ksm + (buf * 64 + 16 * kt + fr) * KST + 32 * ks + 8 * fq);
#pragma unroll
          for (int qi = 0; qi < 2; ++qi) S[kt][qi] = MFMA(ak, qf[qi][ks], S[kt][qi]); }
      bf16x8 pf[2][2];
      if (64 * j + 63 > q0 + 32 * w) {
#pragma unroll
        for (int qi = 0; qi < 2; ++qi) { const int qg = q0 + 32 * w + 16 * qi + fr;
#pragma unroll
          for (int kt = 0; kt < 4; ++kt)
#pragma unroll
            for (int r = 0; r < 4; ++r) { const int kg = 64 * j + 16 * kt + 4 * fq + r; if (kg > qg) S[kt][qi][r] = -1e30f; } }
      }
#pragma unroll
      for (int qi = 0; qi < 2; ++qi) {
        float mx = -3e38f;
        if (BIAS) {
#pragma unroll
          for (int kt = 0; kt < 4; ++kt) { const f32x4 nf = *(const f32x4*)(fkm + buf * 64 + 16 * kt + 4 * fq);
#pragma unroll
            for (int r = 0; r < 4; ++r) { const float t = fmaf(S[kt][qi][r], sc2, nf[r]); S[kt][qi][r] = t; mx = fmaxf(mx, t); } }
        } else {
#pragma unroll
          for (int kt = 0; kt < 4; ++kt)
#pragma unroll
            for (int r = 0; r < 4; ++r) mx = fmaxf(mx, S[kt][qi][r]);
          mx *= sc2;
        }
        mx = fmaxf(mx, __shfl_xor(mx, 16)); mx = fmaxf(mx, __shfl_xor(mx, 32));
        const float mold = mrun[qi], mnew = fmaxf(mold, mx);
        mrun[qi] = mnew;
        float ps = 0.f;
#pragma unroll
        for (int kt = 0; kt < 4; ++kt)
#pragma unroll
          for (int r = 0; r < 4; ++r) { const float pv = BIAS ? __builtin_amdgcn_exp2f(S[kt][qi][r] - mnew) : __builtin_amdgcn_exp2f(fmaf(S[kt][qi][r], sc2, -mnew)); S[kt][qi][r] = pv; ps += pv; }
        {
          const float alpha = __builtin_amdgcn_exp2f(mold - mnew);
          lrun[qi] *= alpha;
#pragma unroll
          for (int et = 0; et < 4; ++et) O[et][qi] *= alpha;
        }
        lrun[qi] += ps;
#pragma unroll
        for (int k2 = 0; k2 < 2; ++k2) { uint2 lo, hi; lo.x = pk_bf16(S[2 * k2][qi][0], S[2 * k2][qi][1]); lo.y = pk_bf16(S[2 * k2][qi][2], S[2 * k2][qi][3]);
          hi.x = pk_bf16(S[2 * k2 + 1][qi][0], S[2 * k2 + 1][qi][1]); hi.y = pk_bf16(S[2 * k2 + 1][qi][2], S[2 * k2 + 1][qi][3]); pf[qi][k2] = mk8(lo, hi); }
      }
#pragma unroll
      for (int k2 = 0; k2 < 2; ++k2)
#pragma unroll
        for (int et = 0; et < 4; ++et) {
          const uint2 v0 = *(const uint2*)(Vtm + (buf * 64 + 16 * et + fr) * 72 + 32 * k2 + 4 * fq), v1 = *(const uint2*)(Vtm + (buf * 64 + 16 * et + fr) * 72 + 32 * k2 + 16 + 4 * fq);
          const bf16x8 va = mk8(v0, v1);
#pragma unroll
          for (int qi = 0; qi < 2; ++qi) O[et][qi] = MFMA(va, pf[qi][k2], O[et][qi]);
        }
    }
    if (j + 1 < nkv) stage(buf ^ 1, sk0, sk1, sv, sfk);
    LBAR();
  };
  for (int j = 0; j < nkv; j += 2) {
    tile_step(j, rk0A, rk1A, rvA, rfkA, rk0B, rk1B, rvB, rfkB);
    if (j + 1 < nkv) tile_step(j + 1, rk0B, rk1B, rvB, rfkB, rk0A, rk1A, rvA, rfkA);
  }
#pragma unroll
  for (int qi = 0; qi < 2; ++qi) {
    const int qg = q0 + 32 * w + 16 * qi + fr;
    float l = lrun[qi]; l += __shfl_xor(l, 16); l += __shfl_xor(l, 32);
    const float inv = 1.0f / l;
    if (qg < qend) {
#pragma unroll
      for (int et = 0; et < 4; ++et) { uint2 o; o.x = pk_bf16(O[et][qi][0] * inv, O[et][qi][1] * inv); o.y = pk_bf16(O[et][qi][2] * inv, O[et][qi][3] * inv);
        *(uint2*)(Op + (size_t)(rowb + qg) * 1024 + 16 * et + 4 * fq) = o; }
    }
  }
}

__device__ __forceinline__ void attn_phase(const Params& p, unsigned char* lds) {
  __shared__ int s_item;
  unsigned* ctr = (unsigned*)(p.ws + OFF_CTR);
  bf16_t* Zo = (bf16_t*)(p.ws + OFF_Z); bf16_t* QR = (bf16_t*)(p.ws + OFF_QRAW); bf16_t* KV = (bf16_t*)(p.ws + OFF_KVRAW);
  bf16_t* KR = (bf16_t*)(p.ws + OFF_KR); bf16_t* Y = (bf16_t*)(p.ws + OFF_XN);
  const float* FC = (const float*)(p.ws + OFF_FCUM);
  for (;;) {
    __syncthreads();
    if (otid() == 0) s_item = (int)atomicAdd(ctr, 1u);
    __syncthreads();
    const int it = s_item;
    if (it >= 17 * 128) break;
    const int k = 16 - it / 128, rem = it & 127, type = rem & 1, hh = (rem >> 1) & 7, b = rem >> 4;
    const int q0 = k ? 16 + 256 * (k - 1) : 0, qend = k ? q0 + 256 : 16, nkv = k ? 4 * k + 1 : 1;
    if (type == 0)
      attn_item<96, false>(lds, QR + hh * 96, 768, KV + hh * 128, 1024, KR, 32, KV + hh * 128 + 64, 1024, nullptr, Y + hh * 64, b, q0, qend, nkv, 0.10206207261596575f);
    else
      attn_item<64, true>(lds, Zo + 672 + hh * 64, LDZO, Zo + 1184 + hh * 64, LDZO, nullptr, 0, Zo + 1696 + hh * 64, LDZO, FC + (size_t)(b * 8 + hh) * T, Y + 512 + hh * 64, b, q0, qend, nkv, 0.125f);
  }
}

template <class Epi>
__device__ __forceinline__ void run_gemm(unsigned char* smem, const bf16_t* A, int lda, const bf16_t* Bt, int N, int K, const Epi& E) {
  pg8::Gemm g{A, Bt, MP, N, K, lda, K};
  pg8::StaticOrder S; S.init(MP, N, (int)gridDim.x, obid());
  pg8::gemm_phase<Epi, pg8::StaticOrder, true, true>((PG8_LAS unsigned char*)smem, g, S, E);
}

template <bool FIRST>
__device__ __forceinline__ void run_gemm_res(const Params& p, unsigned char* smem, const bf16_t* A, int lda, const bf16_t* Bt, int K) {
  { pg8::Gemm g{A, Bt, 32768, 1024, K, lda, K};
    pg8::StaticOrder S; S.init(32768, 1024, (int)gridDim.x, obid());
    pg8::gemm_phase<pg8::EpiRes<FIRST>, pg8::StaticOrder, true, true>((PG8_LAS unsigned char*)smem, g, S, pg8::EpiRes<FIRST>{&p}); }
  { const int c = obid(), ks = c >> 2;
    pg8::TailOrder TS{c, 4 * (K >> 8), 128};
    pg8::Gemm g{A + ks * 256, Bt + ks * 256, MP, 1024, 256, lda, K};
    pg8::gemm_phase<pg8::EpiSlab, pg8::TailOrder, true, true>((PG8_LAS unsigned char*)smem, g, TS, pg8::EpiSlab{(float*)(p.ws + OFF_SLAB), ks}); }
}

__global__ void __launch_bounds__(NT, 2) fwd_megakernel(Params p) {
  cg::grid_group grid = cg::this_grid();
  __shared__ __attribute__((aligned(16))) unsigned char smem[SMEM_BYTES];
  unsigned char* ws = p.ws;
  bf16_t* XN = (bf16_t*)(ws + OFF_XN); bf16_t* Z = (bf16_t*)(ws + OFF_Z); float* GATES = (float*)(ws + OFF_GATES);
  __shared__ uint4 xb_words;
  if (threadIdx.x == 0) xb_words = make_uint4(0u, 0u, 0u, 0u);
  unsigned* barw = (unsigned*)(ws + OFF_BAR);
  if (blockIdx.x == 0) { for (int i = threadIdx.x; i < XCD_BAR_WORDS; i += NT) barw[i] = 0u; if (threadIdx.x == 0) *(unsigned*)(ws + OFF_CTR) = 0u; }
  wconv(smem, p.ev_w_in, (bf16_t*)(ws + OFF_WINE), 1024, 5128, 5376, 1, 1);
  wconv(smem, p.ev_w_out, (bf16_t*)(ws + OFF_WOUTE), 2048, 1024, 1024, 0, 1);
  wconv(smem, p.w_ff1, (bf16_t*)(ws + OFF_FF1), 1024, 4096, 4096, 0, 2);
  wconv(smem, p.w_ff2, (bf16_t*)(ws + OFF_FF2), 4096, 1024, 1024, 0, 2);
  wconv(smem, p.od_w_in, (bf16_t*)(ws + OFF_WINO), 1024, 2216, 2304, 0, 1);
  wconv(smem, p.od_w_uq, (bf16_t*)(ws + OFF_WUQ), 384, 768, 768, 0, 1);
  wconv(smem, p.od_w_ukv, (bf16_t*)(ws + OFF_WUKV), 256, 1024, 1024, 0, 1);
  wconv(smem, p.od_w_out, (bf16_t*)(ws + OFF_WOUTO), 1024, 1024, 1024, 0, 1);
  wconv(smem, p.ev_w_ra, (bf16_t*)(ws + OFF_WRA), 128, 128, 128, 0, 8);
  wconv(smem, p.ev_w_rx, (bf16_t*)(ws + OFF_WRX), 128, 128, 128, 0, 8);
  norm_phase(p, p.ev_ln, 1, 0);
  grid.sync();
  (void)xcd_barrier_post(barw, (volatile LAS unsigned*)&xb_words);
#define GSYNC() do { XcdBarrier xb_; xb_.bar = (unsigned*)(p.ws + OFF_BAR); xb_.x = xb_xcc_id(); xb_.st = (volatile LAS unsigned*)&xb_words; xcd_barrier(xb_); } while (0)
  run_gemm(smem, XN, 1024, (const bf16_t*)(ws + OFF_WINE), 5376, 1024, pg8::EpiZ<0>{Z, LDZE, 5120, GATES});
  GSYNC();
  {
    const int G = (int)gridDim.x;
    for (int pr = obid(); pr < 128; pr += G) mlstm_item8(p, smem, pr);
    { const int b0 = obid();
      for (int pr = b0 >= 128 ? b0 : b0 + G * ((127 - b0) / G + 1); pr < 256; pr += G) rglru_item8(p, smem, pr - 128); }
  }
  GSYNC();
  anorm_phase(p);
  GSYNC();
  run_gemm_res<true>(p, smem, Z + 3072, LDZE, (const bf16_t*)(ws + OFF_WOUTE), 2048);
  GSYNC();
  for (int layer = 0; layer < 2; ++layer) {
    if (layer == 1) {
      norm_phase(p, p.od_ln, 0, 16);
      GSYNC();
      run_gemm(smem, XN, 1024, (const bf16_t*)(ws + OFF_WINO), 2304, 1024, pg8::EpiZ<0>{Z, LDZO, 2208, GATES});
      GSYNC();
      oddprep_phase(p);
      GSYNC();
      run_gemm(smem, Z, LDZO, (const bf16_t*)(ws + OFF_WUQ), 768, 384, pg8::EpiZ<0>{(bf16_t*)(ws + OFF_QRAW), 768, 1 << 30, nullptr});
      run_gemm(smem, Z + 384, LDZO, (const bf16_t*)(ws + OFF_WUKV), 1024, 256, pg8::EpiZ<0>{(bf16_t*)(ws + OFF_KVRAW), 1024, 1 << 30, nullptr});
      for (int it = obid(); it < 64; it += gridDim.x) fcum_item(p, smem, it);
      GSYNC();
      headprep_phase(p);
      GSYNC();
      attn_phase(p, smem);
      GSYNC();
      run_gemm_res<false>(p, smem, XN, 1024, (const bf16_t*)(ws + OFF_WOUTO), 1024);
      GSYNC();
    }
    norm_phase(p, p.mlp_ln + layer * 1024, layer ? 0 : 2, layer ? 4 : 8);
    GSYNC();
    run_gemm(smem, XN, 1024, (const bf16_t*)(ws + OFF_FF1) + (size_t)layer * 4096 * 1024, 4096, 1024, pg8::EpiZ<1>{Z, 4096, 1 << 30, nullptr});
    GSYNC();
    run_gemm_res<false>(p, smem, Z, 4096, (const bf16_t*)(ws + OFF_FF2) + (size_t)layer * 4096 * 1024, 4096);
    GSYNC();
  }
  {
    const int tid = otid(), lane = tid & 63, wave = (obid() * NT + tid) >> 6;
    if (wave < 128) { const int r = 32768 + wave; float* hp = hrow(p, r);
      const float* sl = (const float*)(ws + OFF_SLAB) + (size_t)wave * 1024 + lane * 4;
#pragma unroll
      for (int i = 0; i < 4; ++i) { float4 v = *(const float4*)(hp + i * 256 + lane * 4);
        for (int sI = 0; sI < 16; ++sI) { const float4 a = *(const float4*)(sl + (size_t)sI * 131072 + i * 256); v.x += a.x; v.y += a.y; v.z += a.z; v.w += a.w; }
        *(float4*)(hp + i * 256 + lane * 4) = v; } }
  }
}

extern "C" void kernel_launch(void* const* d_in, const int* in_sizes, int n_in, void* d_out, int out_size,
                              void* d_ws, size_t ws_size, hipStream_t stream) {
  static int grid_blocks = 0;
  if (!grid_blocks) {
    int dev = 0, cus = 0, per_cu = 0;
    (void)hipGetDevice(&dev);
    (void)hipDeviceGetAttribute(&cus, hipDeviceAttributeMultiprocessorCount, dev);
    (void)hipOccupancyMaxActiveBlocksPerMultiprocessor(&per_cu, fwd_megakernel, NT, 0);
    if (per_cu > 1) per_cu = 1;
    if (per_cu < 1) per_cu = 1;
    grid_blocks = cus * per_cu;
  }
  Params p{};
  const float** fp = (const float**)&p;
  (void)fp;
  p.x = (const float*)d_in[0]; p.pos = (const int*)d_in[1]; p.meta = (const float*)d_in[2];
  p.ev_ln = (const float*)d_in[3]; p.ev_w_in = (const float*)d_in[4]; p.ev_b_if = (const float*)d_in[5]; p.ev_a_norm = (const float*)d_in[6];
  p.ev_conv_w = (const float*)d_in[7]; p.ev_conv_b = (const float*)d_in[8]; p.ev_w_ra = (const float*)d_in[9]; p.ev_b_ra = (const float*)d_in[10];
  p.ev_w_rx = (const float*)d_in[11]; p.ev_b_rx = (const float*)d_in[12]; p.ev_lam = (const float*)d_in[13]; p.ev_w_out = (const float*)d_in[14];
  p.od_ln = (const float*)d_in[15]; p.od_w_in = (const float*)d_in[16]; p.od_b_f = (const float*)d_in[17]; p.od_g_qa = (const float*)d_in[18];
  p.od_g_kva = (const float*)d_in[19]; p.od_w_uq = (const float*)d_in[20]; p.od_w_ukv = (const float*)d_in[21]; p.od_g_qn = (const float*)d_in[22];
  p.od_g_qr = (const float*)d_in[23]; p.od_g_kn = (const float*)d_in[24]; p.od_g_kr = (const float*)d_in[25]; p.od_g_fq = (const float*)d_in[26];
  p.od_g_fk = (const float*)d_in[27]; p.od_w_out = (const float*)d_in[28];
  p.mlp_ln = (const float*)d_in[29]; p.w_ff1 = (const float*)d_in[30]; p.w_ff2 = (const float*)d_in[31];
  p.out = (float*)d_out; p.ws = (unsigned char*)d_ws;
  void* args[] = {&p};
  hipError_t e = hipLaunchCooperativeKernel((void*)fwd_megakernel, dim3(grid_blocks), dim3(NT), args, 0, stream);
  if (e != hipSuccess) fprintf(stderr, "cooperative launch failed: %s (grid %d)\n", hipGetErrorString(e), grid_blocks);
}
```

```cpp
#include <hip/hip_runtime.h>
#include <hip/hip_cooperative_groups.h>
#include <cstdio>
#include <cstdint>
namespace cg = cooperative_groups;
namespace pg8 {
#define PG8_LAS __attribute__((address_space(3)))
typedef unsigned short bf16_t;
typedef short bf16x8 __attribute__((ext_vector_type(8)));
typedef float f32x4 __attribute__((ext_vector_type(4)));
typedef unsigned u32x4 __attribute__((ext_vector_type(4)));
constexpr int BM = 256, BK = 64, HALF = 128, HTB = HALF * BK * 2  , STAGE_BYTES = 8 * HTB, NXCD = 8, WGM = 8;

__host__ __device__ __forceinline__ int lds_byte(int r, int c) { const int st = (r >> 4) * 2 + (c >> 5), rr = r & 15, cc = c & 31, ob = rr * 64 + cc * 2; return st * 1024 + (ob ^ (((ob >> 9) & 1) << 5)); }
__host__ __device__ __forceinline__ void stage_rc(int b, int& R, int& C) { const int st = b / 1024, sb = b % 1024, swz = sb ^ (((sb >> 9) & 1) << 5); R = (st >> 1) * 16 + swz / 64; C = (st & 1) * 32 + (swz % 64) / 2; }
__host__ __device__ __forceinline__ int perm32(int rho) { const int n = rho >> 4, i = rho & 15; return 8 * (i >> 2) + 4 * n + (i & 3); }

struct Unit { int pm, pn; };
struct Gemm { const bf16_t* A; const bf16_t* Bt; int M, N, K, lda, ldb; };

struct StaticOrder {
    int nM, nN, nwg, G, c;
    __host__ __device__ void init(int M, int N, int G_, int c_) { nM = M / BM; nN = N / BM; nwg = nM * nN; G = G_; c = c_; }
    __host__ __device__ bool next(int i, Unit& u) const {
        const long L = (long)i * G + c; if (L >= nwg) return false;
        int wgid = (int)L; { const int q = nwg / NXCD, r = nwg % NXCD, xcd = wgid % NXCD, off = wgid / NXCD; wgid = (xcd < r ? xcd * (q + 1) : r * (q + 1) + (xcd - r) * q) + off; }
        const int nig = WGM * nN, gid = wgid / nig, fm = gid * WGM, gsz = (nM - fm) < WGM ? (nM - fm) : WGM;
        u.pm = fm + ((wgid % nig) % gsz); u.pn = (wgid % nig) / gsz; return true;
    }
    __device__ __forceinline__ void a_ready(const Unit&) const {}
    __device__ __forceinline__ void done(const Unit&) const {}
};
}
using pg8::bf16_t; using pg8::bf16x8; using pg8::f32x4;
#define DEVI __device__ __forceinline__

constexpr int T = 4112, NB = 8, M = NB * T, MP = 33024, NT = 512;
constexpr float EPS = 1e-6f;
constexpr float LOG2E = 1.4426950408889634f;

struct Params {
  const float *x; const int* pos; const float* meta;
  const float *ev_ln, *ev_w_in, *ev_b_if, *ev_a_norm, *ev_conv_w, *ev_conv_b, *ev_w_ra, *ev_b_ra, *ev_w_rx, *ev_b_rx, *ev_lam, *ev_w_out;
  const float *od_ln, *od_w_in, *od_b_f, *od_g_qa, *od_g_kva, *od_w_uq, *od_w_ukv, *od_g_qn, *od_g_qr, *od_g_kn, *od_g_kr, *od_g_fq, *od_g_fk, *od_w_out;
  const float *mlp_ln, *w_ff1, *w_ff2;
  float* out; unsigned char* ws;
};

constexpr size_t OFF_WINE  = 0;
constexpr size_t OFF_WOUTE = OFF_WINE + (size_t)5376 * 1024 * 2;
constexpr size_t OFF_FF1   = OFF_WOUTE + (size_t)1024 * 2048 * 2;
constexpr size_t OFF_FF2   = OFF_FF1 + (size_t)2 * 4096 * 1024 * 2;
constexpr size_t OFF_WINO  = OFF_FF2 + (size_t)2 * 4096 * 1024 * 2;
constexpr size_t OFF_WUQ   = OFF_WINO + (size_t)2304 * 1024 * 2;
constexpr size_t OFF_WUKV  = OFF_WUQ + (size_t)768 * 384 * 2;
constexpr size_t OFF_WOUTO = OFF_WUKV + (size_t)1024 * 256 * 2;
constexpr size_t OFF_WRA   = OFF_WOUTO + (size_t)1024 * 1024 * 2;
constexpr size_t OFF_WRX   = OFF_WRA + 262144;
constexpr size_t OFF_HMETA = OFF_WRX + 262144;
constexpr size_t OFF_GATES = OFF_HMETA + 524288;
constexpr size_t OFF_CTR   = OFF_GATES + (size_t)MP * 8 * 4;
constexpr size_t OFF_BAR   = OFF_CTR + 256;
constexpr size_t OFF_XN    = OFF_BAR + 14336;
constexpr size_t OFF_Z     = OFF_XN + (size_t)MP * 1024 * 2;
constexpr int LDZE = 5120;
constexpr int LDZO = 2304;
constexpr size_t OFF_QRAW  = OFF_Z + (size_t)MP * LDZO * 2;
constexpr size_t OFF_KVRAW = OFF_QRAW + (size_t)MP * 768 * 2;
constexpr size_t OFF_KR    = OFF_KVRAW + (size_t)MP * 1024 * 2;
constexpr size_t OFF_ROPE  = OFF_KR + (size_t)MP * 32 * 2;
constexpr size_t OFF_FCUM  = OFF_ROPE + (size_t)MP * 32 * 4;

constexpr size_t OFF_SLAB  = OFF_Z + (size_t)MP * LDZE * 2;
constexpr int HALF_LDS = 69632, SMEM_BYTES = 2 * HALF_LDS;

DEVI unsigned pk_bf16(float lo, float hi) { unsigned r; asm("v_cvt_pk_bf16_f32 %0, %1, %2" : "=v"(r) : "v"(lo), "v"(hi)); return r; }
DEVI float bf_lo(unsigned u) { return __uint_as_float(u << 16); }
DEVI float bf_hi(unsigned u) { return __uint_as_float(u & 0xffff0000u); }
DEVI float bf2f(bf16_t v) { return __uint_as_float(((unsigned)v) << 16); }
DEVI bf16_t f2bf(float f) { return (bf16_t)(pk_bf16(f, 0.f) & 0xffffu); }
DEVI int otid() { int t = threadIdx.x; asm volatile("" : "+v"(t)); return t; }
DEVI int obid() { int t = blockIdx.x; asm volatile("" : "+s"(t)); return t; }
DEVI float wave_sum(float v) { for (int o = 32; o; o >>= 1) v += __shfl_xor(v, o); return v; }
DEVI float sigmoidf_(float x) { return __builtin_amdgcn_rcpf(1.0f + __builtin_amdgcn_exp2f(-x * LOG2E)); }
DEVI float logsigmoidf_(float x) { return fminf(x, 0.f) - 0.6931471805599453f * __builtin_amdgcn_logf(1.0f + __builtin_amdgcn_exp2f(-fabsf(x) * LOG2E)); }
DEVI float neg_expm1_small(float x) { float q = 1.0f / 5040.0f; q = q * x + 1.0f / 720.0f; q = q * x + 1.0f / 120.0f; q = q * x + 1.0f / 24.0f; q = q * x + 1.0f / 6.0f; q = q * x + 0.5f; q = q * x + 1.0f; return -x * q; }
DEVI float* hrow(const Params& p, int r) {
  const int b = r / T, t = r - b * T;
  return t < 16 ? (float*)(p.ws + OFF_HMETA) + (size_t)(b * 16 + t) * 1024 : p.out + ((size_t)b * 4096 + (t - 16)) * 1024;
}
DEVI const float* xrow(const Params& p, int r) { const int b = r / T, t = r - b * T; return t < 16 ? p.meta + (size_t)t * 1024 : p.x + ((size_t)b * 4096 + (t - 16)) * 1024; }
DEVI bf16x8 mk8(uint2 a, uint2 b) { union { uint4 u; bf16x8 v; } c; c.u = make_uint4(a.x, a.y, b.x, b.y); return c.v; }
DEVI bf16x8 mk8u(uint4 a) { union { uint4 u; bf16x8 v; } c; c.u = a; return c.v; }
#define LBAR() do { asm volatile("s_waitcnt lgkmcnt(0)" ::: "memory"); __builtin_amdgcn_s_barrier(); asm volatile("" ::: "memory"); } while (0)
#define HBAR() do { asm volatile("s_waitcnt lgkmcnt(0)" ::: "memory"); hgen += 4u; \
    if (lane == 0) { (void)__hip_atomic_fetch_add(hcnt, 1u, __ATOMIC_RELAXED, __HIP_MEMORY_SCOPE_WORKGROUP); \
      while (__hip_atomic_load(hcnt, __ATOMIC_RELAXED, __HIP_MEMORY_SCOPE_WORKGROUP) < hgen) __builtin_amdgcn_s_sleep(1); } \
    asm volatile("" ::: "memory"); } while (0)
#define MFMA(a, b, c) __builtin_amdgcn_mfma_f32_16x16x32_bf16((a), (b), (c), 0, 0, 0)


namespace pg8 {
template <int ACT> struct EpiZ {
    static constexpr bool PERM = true, AFTER_DRAIN = false;
    bf16_t* O; int ldo; int gate0; float* gates;
    __device__ __forceinline__ void operator()(const f32x4 (&acc)[2][2][4][2], const Unit& u, int wr, int wc, int fr, int fq) const {
        const int row0 = u.pm * BM + wr * 64 + fr, col0 = u.pn * BM + wc * 32 + 8 * fq;
#pragma unroll
        for (int ai = 0; ai < 2; ++ai)
#pragma unroll
            for (int m = 0; m < 4; ++m) { const int row = row0 + ai * HALF + m * 16;
#pragma unroll
                for (int bj = 0; bj < 2; ++bj) { const int col = col0 + bj * HALF; f32x4 v0 = acc[ai][bj][m][0], v1 = acc[ai][bj][m][1];
                    if (ACT == 1) {
#pragma unroll
                        for (int j = 0; j < 4; ++j) { const float a = fmaxf(v0[j], 0.f), b = fmaxf(v1[j], 0.f); v0[j] = a * a; v1[j] = b * b; } }
                    if (col < gate0) { u32x4 w; w.x = pk_bf16(v0[0], v0[1]); w.y = pk_bf16(v0[2], v0[3]); w.z = pk_bf16(v1[0], v1[1]); w.w = pk_bf16(v1[2], v1[3]); *(u32x4*)(O + (size_t)row * ldo + col) = w; }
                    else if (col < gate0 + 8) { float* gp = gates + (size_t)row * 8; *(f32x4*)gp = v0; *(f32x4*)(gp + 4) = v1; } } }
    }
};
template <bool FIRST> struct EpiRes {
    static constexpr bool PERM = false, AFTER_DRAIN = false;
    const Params* p;
    __device__ __forceinline__ void operator()(const f32x4 (&acc)[2][2][4][2], const Unit& u, int wr, int wc, int fr, int fq) const {
        const int row0 = u.pm * BM + wr * 64 + fr, col0 = u.pn * BM + wc * 32 + 4 * fq;
#pragma unroll
        for (int ai = 0; ai < 2; ++ai)
#pragma unroll
            for (int m = 0; m < 4; ++m) { const int row = row0 + ai * HALF + m * 16;
                if (row < M) { float* hp = hrow(*p, row) + col0; const float* sp = FIRST ? xrow(*p, row) + col0 : hp;
#pragma unroll
                    for (int bj = 0; bj < 2; ++bj)
#pragma unroll
                        for (int n = 0; n < 2; ++n) { f32x4 h = *(const f32x4*)(sp + bj * HALF + n * 16); h += acc[ai][bj][m][n]; *(f32x4*)(hp + bj * HALF + n * 16) = h; } } }
    }
};

struct EpiSlab {
    static constexpr bool PERM = false, AFTER_DRAIN = false;
    float* slab; int ks;
    __device__ __forceinline__ void operator()(const f32x4 (&acc)[2][2][4][2], const Unit& u, int wr, int wc, int fr, int fq) const {
        const int col0 = u.pn * BM + wc * 32 + 4 * fq;
#pragma unroll
        for (int m = 0; m < 4; ++m) { float* sp = slab + ((size_t)(ks * 128 + wr * 64 + m * 16 + fr)) * 1024 + col0;
#pragma unroll
            for (int bj = 0; bj < 2; ++bj)
#pragma unroll
                for (int n = 0; n < 2; ++n) *(f32x4*)(sp + bj * HALF + n * 16) = acc[0][bj][m][n]; }
    }
};
struct TailOrder {
    int c, n, pm;
    __device__ __forceinline__ bool next(int i, Unit& u) const { if (i != 0 || c >= n) return false; u.pm = pm; u.pn = c & 3; return true; }
    __device__ __forceinline__ void a_ready(const Unit&) const {}
    __device__ __forceinline__ void done(const Unit&) const {}
};
template <class Epi, class Sched, bool ALIGN_EPI = false, bool SP2 = false>
__device__ __forceinline__ void gemm_phase(PG8_LAS unsigned char* lds, const Gemm g, const Sched& S, const Epi& E) {
    const int tid = otid(), wid = __builtin_amdgcn_readfirstlane(tid >> 6), lane = tid & 63, wr = wid >> 2, wc = wid & 3, fr = lane & 15, fq = lane >> 4;
    const int K = g.K, nt = K / BK;
    unsigned voffA[2], voffB[2];
#pragma unroll
    for (int i = 0; i < 2; ++i) { int R, C; stage_rc(tid * 16 + i * 8192, R, C); const int Rb = Epi::PERM ? ((R & ~31) + perm32(R & 31)) : R;
        voffA[i] = (unsigned)(R * g.lda + C) * 2u; voffB[i] = (unsigned)(Rb * g.ldb + C) * 2u; }
    const size_t kstep = (size_t)(BK * 2);
    const size_t hstepA = (size_t)HALF * g.lda * 2, hstepB = (size_t)HALF * g.ldb * 2;
    const size_t tstepA = 2 * hstepA, tstepB = 2 * hstepB;
    const unsigned ldsw = (unsigned)wid * 1024u;
    const int aoff = lds_byte(wr * 64 + fr, fq * 8), boff = lds_byte(wc * 32 + fr, fq * 8);
#define PG8_SA(b, h) (((b) * 2 + (h)) * HTB)
#define PG8_SB(b, h) ((4 + (b) * 2 + (h)) * HTB)
#define PG8_STAGE(bufoff, gbase, voff) do { _Pragma("unroll") for (int _i = 0; _i < 2; ++_i) \
        __builtin_amdgcn_global_load_lds((const unsigned*)((const char*)(gbase) + (voff)[_i]), (PG8_LAS unsigned*)(lds + (bufoff) + ldsw + _i * 8192), 16, 0, 0); } while (0)
#define PG8_LDA(dst, b, h) do { _Pragma("unroll") for (int m = 0; m < 4; ++m) _Pragma("unroll") for (int k = 0; k < 2; ++k) dst[m][k] = *(const PG8_LAS bf16x8*)(lds + PG8_SA(b, h) + aoff + m * 2048 + k * 1024); } while (0)
#define PG8_LDB(dst, b, h) do { _Pragma("unroll") for (int n = 0; n < 2; ++n) _Pragma("unroll") for (int k = 0; k < 2; ++k) dst[n][k] = *(const PG8_LAS bf16x8*)(lds + PG8_SB(b, h) + boff + n * 2048 + k * 1024); } while (0)
#define PG8_MMA(ai, bj, At, Bt) do { __builtin_amdgcn_s_setprio(1); _Pragma("unroll") for (int m = 0; m < 4; ++m) _Pragma("unroll") for (int n = 0; n < 2; ++n) _Pragma("unroll") for (int k = 0; k < 2; ++k) \
        acc[ai][bj][m][n] = __builtin_amdgcn_mfma_f32_16x16x32_bf16(Bt[n][k], At[m][k], acc[ai][bj][m][n], 0, 0, 0); __builtin_amdgcn_s_setprio(0); } while (0)
#define PG8_WAIT_V(n) asm volatile("s_waitcnt vmcnt(" #n ")" ::: "memory")
#define PG8_WAIT_L(n) asm volatile("s_waitcnt lgkmcnt(" #n ")" ::: "memory")
#define PG8_BAR __builtin_amdgcn_s_barrier()
#define PG8_SCHED __builtin_amdgcn_sched_barrier(0)
    Unit cur, nxt; int ui = 0;
    if (!S.next(0, cur)) return;
    f32x4 acc[2][2][4][2];
#pragma unroll
    for (int a = 0; a < 2; ++a)
#pragma unroll
        for (int b = 0; b < 2; ++b)
#pragma unroll
            for (int m = 0; m < 4; ++m)
#pragma unroll
                for (int n = 0; n < 2; ++n) acc[a][b][m][n] = (f32x4){0.f, 0.f, 0.f, 0.f};
    bf16x8 At[4][2], B0[2][2], B1[2][2];
    const char* cA = (const char*)g.A + (size_t)cur.pm * tstepA; const char* cB = (const char*)g.Bt + (size_t)cur.pn * tstepB;
    S.a_ready(cur);
    if constexpr (SP2) {
        PG8_STAGE(PG8_SB(0, 0), cB, voffB); PG8_STAGE(PG8_SB(0, 1), cB + hstepB, voffB); PG8_STAGE(PG8_SA(0, 0), cA, voffA); PG8_STAGE(PG8_SA(0, 1), cA + hstepA, voffA);
        if (wr == 1) PG8_BAR;
        PG8_WAIT_V(2); PG8_BAR;
        PG8_STAGE(PG8_SB(1, 0), cB + kstep, voffB); PG8_STAGE(PG8_SA(1, 0), cA + kstep, voffA); PG8_STAGE(PG8_SB(1, 1), cB + hstepB + kstep, voffB);
        PG8_WAIT_V(6); PG8_BAR;
    } else {
        PG8_STAGE(PG8_SB(0, 0), cB, voffB); PG8_STAGE(PG8_SA(0, 0), cA, voffA); PG8_STAGE(PG8_SB(0, 1), cB + hstepB, voffB); PG8_STAGE(PG8_SA(0, 1), cA + hstepA, voffA);
        if (wr == 1) PG8_BAR;
        PG8_WAIT_V(4); PG8_BAR;
        PG8_STAGE(PG8_SB(1, 0), cB + kstep, voffB); PG8_STAGE(PG8_SA(1, 0), cA + kstep, voffA); PG8_STAGE(PG8_SB(1, 1), cB + hstepB + kstep, voffB);
        PG8_WAIT_V(6); PG8_BAR;
    }
    for (;;) {
        const bool has_next = S.next(ui + 1, nxt);
        const char* nA = has_next ? (const char*)g.A + (size_t)nxt.pm * tstepA : cA; const char* nB = has_next ? (const char*)g.Bt + (size_t)nxt.pn * tstepB : cB;
        for (int t = 0; t < nt; t += 2) {
            const bool last = (t == nt - 2);
            const char* a1 = cA + (size_t)(t + 1) * kstep;
            const char* a2 = last ? nA : cA + (size_t)(t + 2) * kstep; const char* b2 = last ? nB : cB + (size_t)(t + 2) * kstep;
            const char* a3 = a2 + kstep; const char* b3 = b2 + kstep;
            if (last && has_next) S.a_ready(nxt);
            if constexpr (SP2) {
            PG8_LDB(B0, 0, 0); PG8_LDB(B1, 0, 1); PG8_SCHED; PG8_LDA(At, 0, 0); PG8_STAGE(PG8_SA(1, 1), a1 + hstepA, voffA);
            PG8_WAIT_V(8); PG8_WAIT_L(0); PG8_BAR; PG8_MMA(0, 0, At, B0); PG8_MMA(0, 1, At, B1); PG8_BAR; PG8_SCHED;
            PG8_LDA(At, 0, 1); PG8_STAGE(PG8_SB(0, 0), b2, voffB); PG8_STAGE(PG8_SB(0, 1), b2 + hstepB, voffB); PG8_STAGE(PG8_SA(0, 0), a2, voffA);
            PG8_WAIT_V(8); PG8_WAIT_L(0); PG8_BAR; PG8_MMA(1, 0, At, B0); PG8_MMA(1, 1, At, B1); PG8_BAR; PG8_SCHED;
            PG8_LDB(B0, 1, 0); PG8_LDB(B1, 1, 1); PG8_SCHED; PG8_LDA(At, 1, 0); PG8_STAGE(PG8_SA(0, 1), a2 + hstepA, voffA);
            PG8_WAIT_V(8); PG8_WAIT_L(0); PG8_BAR; PG8_MMA(0, 0, At, B0); PG8_MMA(0, 1, At, B1); PG8_BAR; PG8_SCHED;
            PG8_LDA(At, 1, 1); PG8_STAGE(PG8_SB(1, 0), b3, voffB); PG8_STAGE(PG8_SB(1, 1), b3 + hstepB, voffB); PG8_STAGE(PG8_SA(1, 0), a3, voffA);
            PG8_WAIT_V(8); PG8_WAIT_L(0); PG8_BAR; PG8_MMA(1, 0, At, B0); PG8_MMA(1, 1, At, B1); PG8_BAR; PG8_SCHED;
            } else {
            PG8_LDB(B0, 0, 0); PG8_SCHED; PG8_LDA(At, 0, 0); PG8_STAGE(PG8_SA(1, 1), a1 + hstepA, voffA);
            PG8_WAIT_L(8); PG8_BAR; PG8_WAIT_L(0); PG8_MMA(0, 0, At, B0); PG8_BAR; PG8_SCHED;
            PG8_LDB(B1, 0, 1); PG8_STAGE(PG8_SB(0, 0), b2, voffB);
            PG8_BAR; PG8_WAIT_L(0); PG8_MMA(0, 1, At, B1); PG8_BAR;
            PG8_LDA(At, 0, 1); PG8_STAGE(PG8_SA(0, 0), a2, voffA);
            PG8_BAR; PG8_WAIT_L(0); PG8_MMA(1, 0, At, B0); PG8_BAR; PG8_SCHED;
            PG8_STAGE(PG8_SB(0, 1), b2 + hstepB, voffB);
            PG8_WAIT_V(6); PG8_BAR; PG8_MMA(1, 1, At, B1); PG8_BAR;
            PG8_LDB(B0, 1, 0); PG8_SCHED; PG8_LDA(At, 1, 0); PG8_STAGE(PG8_SA(0, 1), a2 + hstepA, voffA);
            PG8_WAIT_L(8); PG8_BAR; PG8_WAIT_L(0); PG8_MMA(0, 0, At, B0); PG8_BAR; PG8_SCHED;
            PG8_LDB(B1, 1, 1); PG8_STAGE(PG8_SB(1, 0), b3, voffB);
            PG8_BAR; PG8_WAIT_L(0); PG8_MMA(0, 1, At, B1); PG8_BAR;
            PG8_LDA(At, 1, 1); PG8_STAGE(PG8_SA(1, 0), a3, voffA);
            PG8_BAR; PG8_WAIT_L(0); PG8_MMA(1, 0, At, B0); PG8_BAR; PG8_SCHED;
            PG8_STAGE(PG8_SB(1, 1), b3 + hstepB, voffB);
            PG8_WAIT_V(6); PG8_BAR; PG8_MMA(1, 1, At, B1); PG8_BAR;
            }
        }
        if constexpr (ALIGN_EPI) { if (wr == 0) PG8_BAR; }
        if constexpr (!Epi::AFTER_DRAIN) { E(acc, cur, wr, wc, fr, fq); S.done(cur); }
        if (!has_next) break;
#pragma unroll
        for (int a = 0; a < 2; ++a)
#pragma unroll
            for (int b = 0; b < 2; ++b)
#pragma unroll
                for (int m = 0; m < 4; ++m)
#pragma unroll
                    for (int n = 0; n < 2; ++n) acc[a][b][m][n] = (f32x4){0.f, 0.f, 0.f, 0.f};
        cur = nxt; cA = nA; cB = nB; ++ui;
        if constexpr (ALIGN_EPI) { if (wr == 1) PG8_BAR; }
    }
    PG8_WAIT_V(0);
    if constexpr (!ALIGN_EPI) { if (wr == 0) PG8_BAR; }
    PG8_BAR;
    if constexpr (Epi::AFTER_DRAIN) { E.fused(acc, cur, wr, wc, fr, fq, lds, wid, lane); S.done(cur); }
#undef PG8_SA
#undef PG8_SB
#undef PG8_STAGE
#undef PG8_LDA
#undef PG8_LDB
#undef PG8_MMA
#undef PG8_WAIT_V
#undef PG8_WAIT_L
#undef PG8_BAR
#undef PG8_SCHED
}
}
__device__ __forceinline__ void wconv(unsigned char* lds, const float* __restrict__ src, bf16_t* __restrict__ dst, int K, int Nsrc, int Ndst, int mode, int nbatch) {
  float* tile = (float*)lds;
  const int tid = otid();
  const int tk = K >> 6, tn = Ndst >> 6, per = tk * tn, total = per * nbatch;
  for (int it = obid(); it < total; it += gridDim.x) {
    const int bi = it / per, rem = it - bi * per, kt = rem / tn, nt = rem - kt * tn;
    const float* s = src + (size_t)bi * K * Nsrc; bf16_t* d = dst + (size_t)bi * Ndst * K;
    const int nn = tid & 63, dcol = nt * 64 + nn;
    int scol; float scale = 1.f;
    if (mode == 0) scol = dcol < Nsrc ? dcol : -1;
    else {
      if (dcol < 2048) { scol = dcol; if (dcol >= 512 && dcol < 1024) scale = 0.08838834764831845f; }
      else if (dcol < 3072) scol = dcol - 2048 + 3080;
      else if (dcol < 4096) scol = dcol - 3072 + 2048;
      else if (dcol < 5120) scol = dcol - 4096 + 4104;
      else if (dcol < 5128) scol = dcol - 5120 + 3072;
      else scol = -1;
    }
    __syncthreads();
#pragma unroll
    for (int i = 0; i < 8; ++i) {
      const int kk = (tid >> 6) + 8 * i;
      float v = 0.f; if (scol >= 0) v = s[(size_t)(kt * 64 + kk) * Nsrc + scol] * scale;
      tile[kk * 65 + nn] = v;
    }
    __syncthreads();
    {
      const int q = tid, n2 = q >> 3, kc = q & 7;
      float v[8];
#pragma unroll
      for (int j = 0; j < 8; ++j) v[j] = tile[(kc * 8 + j) * 65 + n2];
      uint4 w = make_uint4(pk_bf16(v[0], v[1]), pk_bf16(v[2], v[3]), pk_bf16(v[4], v[5]), pk_bf16(v[6], v[7]));
      *(uint4*)(d + (size_t)(nt * 64 + n2) * K + kt * 64 + kc * 8) = w;
    }
  }
  __syncthreads();
}

__device__ __forceinline__ void norm_phase(const Params& p, const float* __restrict__ gain, int mode, int nslab) {
  const int tid = otid(); const int lane = tid & 63, wave = (obid() * NT + tid) >> 6, nw = gridDim.x * (NT / 64);
  bf16_t* xn = (bf16_t*)(p.ws + OFF_XN);
  auto srcrow = [&](int r) -> const float* {
    if (mode == 1 || (mode == 2 && r >= 32768)) return xrow(p, r);
    return hrow(p, r); };
  float4 v[4], vn[4];
  if (wave < M) { const float* src = srcrow(wave);
#pragma unroll
    for (int i = 0; i < 4; ++i) vn[i] = *(const float4*)(src + i * 256 + lane * 4); }
  for (int r = wave; r < M; r += nw) {
    float* hp = hrow(p, r);
#pragma unroll
    for (int i = 0; i < 4; ++i) v[i] = vn[i];
    if (r + nw < M) { const float* src = srcrow(r + nw);
#pragma unroll
      for (int i = 0; i < 4; ++i) vn[i] = *(const float4*)(src + i * 256 + lane * 4); }
    if (nslab > 0 && r >= 32768) {
      const float* sl = (const float*)(p.ws + OFF_SLAB) + (size_t)(r - 32768) * 1024 + lane * 4;
      for (int sI = 0; sI < nslab; ++sI)
#pragma unroll
        for (int i = 0; i < 4; ++i) { const float4 a = *(const float4*)(sl + (size_t)sI * 131072 + i * 256); v[i].x += a.x; v[i].y += a.y; v[i].z += a.z; v[i].w += a.w; }
#pragma unroll
      for (int i = 0; i < 4; ++i) *(float4*)(hp + i * 256 + lane * 4) = v[i];
    }
    float ss = 0.f;
#pragma unroll
    for (int i = 0; i < 4; ++i) ss += v[i].x * v[i].x + v[i].y * v[i].y + v[i].z * v[i].z + v[i].w * v[i].w;
    ss = wave_sum(ss);
    const float rs = rsqrtf(ss * (1.0f / 1024.0f) + EPS);
#pragma unroll
    for (int i = 0; i < 4; ++i) {
      const float4 g = *(const float4*)(gain + i * 256 + lane * 4);
      uint2 w; w.x = pk_bf16(v[i].x * rs * g.x, v[i].y * rs * g.y); w.y = pk_bf16(v[i].z * rs * g.z, v[i].w * rs * g.w);
      *(uint2*)(xn + (size_t)r * 1024 + i * 256 + lane * 4) = w;
    }
  }
}

__device__ __forceinline__ void mlstm_item(const Params& p, unsigned char* lds, int item, const int tid, unsigned* hcnt, unsigned& hgen) {
  const int w = tid >> 6, lane = tid & 63, fr = lane & 15, fq = lane >> 4;
  const int sl = item & 7, hh = (item >> 3) & 3, b = item >> 5;
  bf16_t* Z = (bf16_t*)(p.ws + OFF_Z);
  const float* GE = (const float*)(p.ws + OFF_GATES);
  bf16_t* Qs = (bf16_t*)lds;
  bf16_t* Ks = Qs + 64 * 136;
  bf16_t* Kt = Ks + 64 * 136;
  bf16_t* Vt = Kt + 128 * 72;
  bf16_t* Ct = Vt + 32 * 72;
  float* fv = (float*)(Ct + 32 * 136);
  float *rowt = fv, *cols = fv + 64, *winter = fv + 128, *emr = fv + 192, *wkv = fv + 256, *denv = fv + 320, *qn = fv + 384, *nv = fv + 448, *scal = fv + 576;
  const float bI = p.ev_b_if[hh], bF = p.ev_b_if[4 + hh];
  f32x4 Cacc[2][2];
#pragma unroll
  for (int i = 0; i < 2; ++i)
#pragma unroll
    for (int j = 0; j < 2; ++j) Cacc[i][j] = (f32x4){0.f, 0.f, 0.f, 0.f};
  float m_state = 0.f;
  HBAR();
  if (tid < 128) nv[tid] = 0.f;
  uint4 rqA[4], rkA[4], rvA, rqB[4], rkB[4], rvB; float giA = 0.f, gfA = 0.f, giB = 0.f, gfB = 0.f;
  auto prefetch = [&](int c, uint4 (&rq)[4], uint4 (&rk)[4], uint4& rv, float& gi, float& gf) {
#pragma unroll
    for (int i = 0; i < 4; ++i) {
      const int tok = 64 * c - 48 + lane;
      if (tok >= 0) { const bf16_t* s = Z + (size_t)(b * T + tok) * LDZE + hh * 128 + (4 * w + i) * 8; rq[i] = *(const uint4*)s; rk[i] = *(const uint4*)(s + 512); }
      else { rq[i] = make_uint4(0, 0, 0, 0); rk[i] = make_uint4(0, 0, 0, 0); }
    }
    { const int tok = 64 * c - 48 + lane;
      if (tok >= 0) rv = *(const uint4*)(Z + (size_t)(b * T + tok) * LDZE + 1024 + hh * 256 + sl * 32 + w * 8); else rv = make_uint4(0, 0, 0, 0); }
    if (w == 0) { const int tok = 64 * c - 48 + lane; if (tok >= 0) { gi = GE[(size_t)(b * T + tok) * 8 + hh]; gf = GE[(size_t)(b * T + tok) * 8 + 4 + hh]; } }
  };
  prefetch(0, rqA, rkA, rvA, giA, gfA); prefetch(1, rqB, rkB, rvB, giB, gfB);
  auto chunk_step = [&](const int c, uint4 (&rq)[4], uint4 (&rk)[4], uint4& rv, float& gi, float& gf) {
    if (w == 0) {
      const bool valid = (c > 0) || (lane >= 48);
      const float lf = valid ? logsigmoidf_(gf + bF) : 0.f;
      const float li = valid ? gi + bI : -INFINITY;
      float bb = lf;
#pragma unroll
      for (int o = 1; o < 64; o <<= 1) { const float t = __shfl_up(bb, o); if (lane >= o) bb += t; }
      const float g = __shfl(bb, 63);
      const float cs = li - bb;
      float pm = cs;
#pragma unroll
      for (int o = 1; o < 64; o <<= 1) { const float t = __shfl_up(pm, o); if (lane >= o) pm = fmaxf(pm, t); }
      const float pmax = __shfl(pm, 63);
      const float inter = bb + m_state, mrow = fmaxf(inter, bb + pm);
      rowt[lane] = bb - mrow; cols[lane] = cs; winter[lane] = __expf(inter - mrow); emr[lane] = __expf(-mrow);
      const float m_new = fmaxf(g + m_state, g + pmax);
      wkv[lane] = __expf(g + cs - m_new);
      if (lane == 0) scal[0] = __expf(g + m_state - m_new);
      m_state = m_new;
    }
#pragma unroll
    for (int i = 0; i < 4; ++i) { *(uint4*)(Qs + lane * 136 + (4 * w + i) * 8) = rq[i]; *(uint4*)(Ks + lane * 136 + (4 * w + i) * 8) = rk[i]; }
    { const unsigned vv[4] = {rv.x, rv.y, rv.z, rv.w};
#pragma unroll
      for (int j = 0; j < 4; ++j) { Vt[(w * 8 + 2 * j) * 72 + lane] = (bf16_t)(vv[j] & 0xffffu); Vt[(w * 8 + 2 * j + 1) * 72 + lane] = (bf16_t)(vv[j] >> 16); } }
#pragma unroll
    for (int dt = 0; dt < 2; ++dt)
#pragma unroll
      for (int et = 0; et < 2; ++et) { uint2 wv; wv.x = pk_bf16(Cacc[dt][et][0], Cacc[dt][et][1]); wv.y = pk_bf16(Cacc[dt][et][2], Cacc[dt][et][3]);
        *(uint2*)(Ct + (16 * et + fr) * 136 + 16 * (2 * w + dt) + 4 * fq) = wv; }
    HBAR();
#pragma unroll
    for (int i = 0; i < 4; ++i) {
      const float wks = wkv[lane];
      const unsigned kk[4] = {rk[i].x, rk[i].y, rk[i].z, rk[i].w};
#pragma unroll
      for (int j = 0; j < 4; ++j) { const unsigned pr = pk_bf16(bf_lo(kk[j]) * wks, bf_hi(kk[j]) * wks);
        Kt[((4 * w + i) * 8 + 2 * j) * 72 + lane] = (bf16_t)(pr & 0xffffu); Kt[((4 * w + i) * 8 + 2 * j + 1) * 72 + lane] = (bf16_t)(pr >> 16); }
    }
    if (c + 2 < 65) prefetch(c + 2, rq, rk, rv, gi, gf);
    f32x4 S[4];
#pragma unroll
    for (int st = 0; st < 4; ++st) S[st] = (f32x4){0.f, 0.f, 0.f, 0.f};
#pragma unroll
    for (int ks = 0; ks < 4; ++ks) {
      const bf16x8 bq = *(const bf16x8*)(Qs + (16 * w + fr) * 136 + 32 * ks + 8 * fq);
#pragma unroll
      for (int st = 0; st < 4; ++st) if (st <= w) { const bf16x8 ak = *(const bf16x8*)(Ks + (16 * st + fr) * 136 + 32 * ks + 8 * fq); S[st] = MFMA(ak, bq, S[st]); }
    }
    const float rt = rowt[16 * w + fr];
    float dsum = 0.f;
#pragma unroll
    for (int st = 0; st < 4; ++st)
#pragma unroll
      for (int r = 0; r < 4; ++r) {
        const int s = 16 * st + 4 * fq + r, t = 16 * w + fr;
        float v = 0.f; if (st <= w && s <= t) v = S[st][r] * __expf(rt + cols[s]);
        S[st][r] = v; dsum += v;
      }
    dsum += __shfl_xor(dsum, 16); dsum += __shfl_xor(dsum, 32);
    if (fq == 0) denv[16 * w + fr] = dsum;
    bf16x8 pa[2];
#pragma unroll
    for (int k2 = 0; k2 < 2; ++k2) { uint2 lo, hi; lo.x = pk_bf16(S[2 * k2][0], S[2 * k2][1]); lo.y = pk_bf16(S[2 * k2][2], S[2 * k2][3]);
      hi.x = pk_bf16(S[2 * k2 + 1][0], S[2 * k2 + 1][1]); hi.y = pk_bf16(S[2 * k2 + 1][2], S[2 * k2 + 1][3]); pa[k2] = mk8(lo, hi); }
    {
      const int t = tid >> 2, part = tid & 3; float s = 0.f;
#pragma unroll
      for (int j = 0; j < 4; ++j) { const uint4 qv = *(const uint4*)(Qs + t * 136 + part * 32 + j * 8); const float* np = nv + part * 32 + j * 8;
        s += bf_lo(qv.x) * np[0] + bf_hi(qv.x) * np[1] + bf_lo(qv.y) * np[2] + bf_hi(qv.y) * np[3] + bf_lo(qv.z) * np[4] + bf_hi(qv.z) * np[5] + bf_lo(qv.w) * np[6] + bf_hi(qv.w) * np[7]; }
      s += __shfl_xor(s, 1); s += __shfl_xor(s, 2);
      if (part == 0) qn[t] = s;
    }
    HBAR();
    f32x4 intra[2], inter[2];
#pragma unroll
    for (int et = 0; et < 2; ++et) { intra[et] = (f32x4){0.f, 0.f, 0.f, 0.f}; inter[et] = (f32x4){0.f, 0.f, 0.f, 0.f}; }
#pragma unroll
    for (int k2 = 0; k2 < 2; ++k2) if (2 * k2 <= w) {
#pragma unroll
      for (int et = 0; et < 2; ++et) {
        const uint2 v0 = *(const uint2*)(Vt + (16 * et + fr) * 72 + 32 * k2 + 4 * fq), v1 = *(const uint2*)(Vt + (16 * et + fr) * 72 + 32 * k2 + 16 + 4 * fq);
        intra[et] = MFMA(pa[k2], mk8(v0, v1), intra[et]);
      }
    }
#pragma unroll
    for (int kd = 0; kd < 4; ++kd) {
      const bf16x8 aq = *(const bf16x8*)(Qs + (16 * w + fr) * 136 + 32 * kd + 8 * fq);
#pragma unroll
      for (int et = 0; et < 2; ++et) { const bf16x8 cb = *(const bf16x8*)(Ct + (16 * et + fr) * 136 + 32 * kd + 8 * fq); inter[et] = MFMA(aq, cb, inter[et]); }
    }
#pragma unroll
    for (int r = 0; r < 4; ++r) {
      const int tl = 16 * w + 4 * fq + r, tok = 64 * c - 48 + tl;
      const float wi = winter[tl], dn = wi * qn[tl] + denv[tl], dd = fmaxf(fabsf(dn), emr[tl]), inv = 1.0f / dd;
      if (tok >= 0) {
#pragma unroll
        for (int et = 0; et < 2; ++et) Z[(size_t)(b * T + tok) * LDZE + 1024 + hh * 256 + sl * 32 + 16 * et + fr] = f2bf((wi * inter[et][r] + intra[et][r]) * inv);
      }
    }
    const float sc = scal[0];
#pragma unroll
    for (int dt = 0; dt < 2; ++dt)
#pragma unroll
      for (int et = 0; et < 2; ++et) {
        f32x4 a = Cacc[dt][et] * sc;
#pragma unroll
        for (int ks = 0; ks < 2; ++ks) { const bf16x8 ak = *(const bf16x8*)(Kt + (16 * (2 * w + dt) + fr) * 72 + 32 * ks + 8 * fq); const bf16x8 vb = *(const bf16x8*)(Vt + (16 * et + fr) * 72 + 32 * ks + 8 * fq); a = MFMA(ak, vb, a); }
        Cacc[dt][et] = a;
      }
    if (tid < 128) { float s = 0.f;
#pragma unroll
      for (int j = 0; j < 8; ++j) { const uint4 kv = *(const uint4*)(Kt + tid * 72 + j * 8); s += bf_lo(kv.x) + bf_hi(kv.x) + bf_lo(kv.y) + bf_hi(kv.y) + bf_lo(kv.z) + bf_hi(kv.z) + bf_lo(kv.w) + bf_hi(kv.w); }
      nv[tid] = sc * nv[tid] + s; }
    HBAR();
  };
  for (int c = 0; c < 65; c += 2) {
    chunk_step(c, rqA, rkA, rvA, giA, gfA);
    if (c + 1 < 65) chunk_step(c + 1, rqB, rkB, rvB, giB, gfB);
  }
}

__device__ __forceinline__ void mlstm_item8(const Params& p, unsigned char* lds, int item) {
  const int tid = otid(), w = __builtin_amdgcn_readfirstlane(tid >> 6), lane = tid & 63, fr = lane & 15, fq = lane >> 4;
  const int s2 = item & 3, hh = (item >> 2) & 3, b = item >> 4;
  bf16_t* Z = (bf16_t*)(p.ws + OFF_Z);
  const float* GE = (const float*)(p.ws + OFF_GATES);
  bf16_t* Qs = (bf16_t*)lds;
  bf16_t* Ks = Qs + 64 * 136;
  bf16_t* Kt = Ks + 64 * 136;
  bf16_t* Vt = Kt + 128 * 72;
  bf16_t* Ct = Vt + 64 * 72;
  bf16_t* Sp = Ct + 64 * 136;
  float* fv = (float*)(Sp + 64 * 72);
  float *rowt = fv, *cols = fv + 64, *winter = fv + 128, *emr = fv + 192, *wkv = fv + 256, *qn = fv + 320, *nv = fv + 384, *scal = fv + 512, *dpart = fv + 576;
  const float bI = p.ev_b_if[hh], bF = p.ev_b_if[4 + hh];
  f32x4 Cacc[4];
#pragma unroll
  for (int j = 0; j < 4; ++j) Cacc[j] = (f32x4){0.f, 0.f, 0.f, 0.f};
  float m_state = 0.f;
  __syncthreads();
  if (tid < 128) nv[tid] = 0.f;
  uint4 rq[2], rk[2], rv; float gi = 0.f, gf = 0.f;
  auto prefetch = [&](int c) {
    const int tok = 64 * c - 48 + lane;
    if (tok >= 0) { const bf16_t* sp = Z + (size_t)(b * T + tok) * LDZE + hh * 128 + (2 * w) * 8; rq[0] = *(const uint4*)sp; rq[1] = *(const uint4*)(sp + 8); rk[0] = *(const uint4*)(sp + 512); rk[1] = *(const uint4*)(sp + 520);
      rv = *(const uint4*)(Z + (size_t)(b * T + tok) * LDZE + 1024 + hh * 256 + s2 * 64 + w * 8); }
    else { rq[0] = rq[1] = rk[0] = rk[1] = rv = make_uint4(0, 0, 0, 0); }
    if (w == 0 && tok >= 0) { gi = GE[(size_t)(b * T + tok) * 8 + hh]; gf = GE[(size_t)(b * T + tok) * 8 + 4 + hh]; }
  };
  prefetch(0);
  for (int c = 0; c < 65; ++c) {
    if (w == 0) {
      const bool valid = (c > 0) || (lane >= 48);
      const float lf = valid ? logsigmoidf_(gf + bF) : 0.f;
      const float li = valid ? gi + bI : -INFINITY;
      float bb = lf;
#pragma unroll
      for (int o = 1; o < 64; o <<= 1) { const float t = __shfl_up(bb, o); if (lane >= o) bb += t; }
      const float g = __shfl(bb, 63);
      const float cs = li - bb;
      float pm = cs;
#pragma unroll
      for (int o = 1; o < 64; o <<= 1) { const float t = __shfl_up(pm, o); if (lane >= o) pm = fmaxf(pm, t); }
      const float pmax = __shfl(pm, 63);
      const float inter = bb + m_state, mrow = fmaxf(inter, bb + pm);
      rowt[lane] = bb - mrow; cols[lane] = cs; winter[lane] = __expf(inter - mrow); emr[lane] = __expf(-mrow);
      const float m_new = fmaxf(g + m_state, g + pmax);
      wkv[lane] = __expf(g + cs - m_new);
      if (lane == 0) scal[0] = __expf(g + m_state - m_new);
      m_state = m_new;
    }
#pragma unroll
    for (int i = 0; i < 2; ++i) { *(uint4*)(Qs + lane * 136 + (2 * w + i) * 8) = rq[i]; *(uint4*)(Ks + lane * 136 + (2 * w + i) * 8) = rk[i]; }
    { const unsigned vv[4] = {rv.x, rv.y, rv.z, rv.w};
#pragma unroll
      for (int j = 0; j < 4; ++j) { Vt[(w * 8 + 2 * j) * 72 + lane] = (bf16_t)(vv[j] & 0xffffu); Vt[(w * 8 + 2 * j + 1) * 72 + lane] = (bf16_t)(vv[j] >> 16); } }
#pragma unroll
    for (int et = 0; et < 4; ++et) { uint2 wv; wv.x = pk_bf16(Cacc[et][0], Cacc[et][1]); wv.y = pk_bf16(Cacc[et][2], Cacc[et][3]);
      *(uint2*)(Ct + (16 * et + fr) * 136 + 16 * w + 4 * fq) = wv; }
    LBAR();
    { const float wks = wkv[lane];
#pragma unroll
      for (int i = 0; i < 2; ++i) { const unsigned kk[4] = {rk[i].x, rk[i].y, rk[i].z, rk[i].w};
#pragma unroll
        for (int j = 0; j < 4; ++j) { const unsigned pr = pk_bf16(bf_lo(kk[j]) * wks, bf_hi(kk[j]) * wks);
          Kt[((2 * w + i) * 8 + 2 * j) * 72 + lane] = (bf16_t)(pr & 0xffffu); Kt[((2 * w + i) * 8 + 2 * j + 1) * 72 + lane] = (bf16_t)(pr >> 16); } } }
    if (c + 1 < 65) prefetch(c + 1);
    auto stile = [&](const int st, const int tt) {
      f32x4 S = (f32x4){0.f, 0.f, 0.f, 0.f};
#pragma unroll
      for (int ks = 0; ks < 4; ++ks) { const bf16x8 ak = *(const bf16x8*)(Ks + (16 * st + fr) * 136 + 32 * ks + 8 * fq); const bf16x8 bq = *(const bf16x8*)(Qs + (16 * tt + fr) * 136 + 32 * ks + 8 * fq); S = MFMA(ak, bq, S); }
      const int t = 16 * tt + fr; const float rt = rowt[t]; float ds = 0.f;
#pragma unroll
      for (int r = 0; r < 4; ++r) { const int sI = 16 * st + 4 * fq + r; float v = 0.f; if (sI <= t) v = S[r] * __expf(rt + cols[sI]); S[r] = v; ds += v; }
      ds += __shfl_xor(ds, 16); ds += __shfl_xor(ds, 32);
      if (fq == 0) dpart[st * 64 + t] = ds;
      uint2 wv; wv.x = pk_bf16(S[0], S[1]); wv.y = pk_bf16(S[2], S[3]);
      *(uint2*)(Sp + t * 72 + 16 * st + 4 * fq) = wv;
    };
    if (w == 0) { stile(0, 0); stile(0, 3); }
    else if (w == 1) { stile(0, 1); stile(1, 3); }
    else if (w == 2) { stile(1, 1); stile(2, 3); }
    else if (w == 3) { stile(0, 2); stile(3, 3); }
    else if (w == 4) { stile(1, 2); }
    else if (w == 5) { stile(2, 2); }
    {
      const int t = tid >> 3, part = tid & 7; float sacc = 0.f;
#pragma unroll
      for (int j = 0; j < 2; ++j) { const uint4 qv = *(const uint4*)(Qs + t * 136 + part * 16 + j * 8); const float* np = nv + part * 16 + j * 8;
        sacc += bf_lo(qv.x) * np[0] + bf_hi(qv.x) * np[1] + bf_lo(qv.y) * np[2] + bf_hi(qv.y) * np[3] + bf_lo(qv.z) * np[4] + bf_hi(qv.z) * np[5] + bf_lo(qv.w) * np[6] + bf_hi(qv.w) * np[7]; }
      sacc += __shfl_xor(sacc, 1); sacc += __shfl_xor(sacc, 2); sacc += __shfl_xor(sacc, 4);
      if (part == 0) qn[t] = sacc;
    }
    LBAR();
    { const int tt = w & 3, eh = w >> 2;
      f32x4 intra[2], inter[2];
#pragma unroll
      for (int e2 = 0; e2 < 2; ++e2) { intra[e2] = (f32x4){0.f, 0.f, 0.f, 0.f}; inter[e2] = (f32x4){0.f, 0.f, 0.f, 0.f}; }
#pragma unroll
      for (int k2 = 0; k2 < 2; ++k2) if (2 * k2 <= tt) {
        const uint2 a0 = *(const uint2*)(Sp + (16 * tt + fr) * 72 + 32 * k2 + 4 * fq);
        uint2 a1 = make_uint2(0u, 0u); if (2 * k2 + 1 <= tt) a1 = *(const uint2*)(Sp + (16 * tt + fr) * 72 + 32 * k2 + 16 + 4 * fq);
        const bf16x8 pa = mk8(a0, a1);
#pragma unroll
        for (int e2 = 0; e2 < 2; ++e2) { const int et = 2 * eh + e2;
          const uint2 v0 = *(const uint2*)(Vt + (16 * et + fr) * 72 + 32 * k2 + 4 * fq), v1 = *(const uint2*)(Vt + (16 * et + fr) * 72 + 32 * k2 + 16 + 4 * fq);
          intra[e2] = MFMA(pa, mk8(v0, v1), intra[e2]); }
      }
#pragma unroll
      for (int kd = 0; kd < 4; ++kd) { const bf16x8 aq = *(const bf16x8*)(Qs + (16 * tt + fr) * 136 + 32 * kd + 8 * fq);
#pragma unroll
        for (int e2 = 0; e2 < 2; ++e2) { const bf16x8 cb = *(const bf16x8*)(Ct + (16 * (2 * eh + e2) + fr) * 136 + 32 * kd + 8 * fq); inter[e2] = MFMA(aq, cb, inter[e2]); } }
#pragma unroll
      for (int r = 0; r < 4; ++r) {
        const int tl = 16 * tt + 4 * fq + r, tok = 64 * c - 48 + tl;
        float dsum = 0.f;
#pragma unroll
        for (int st = 0; st < 4; ++st) if (st <= tt) dsum += dpart[st * 64 + tl];
        const float wi = winter[tl], dn = wi * qn[tl] + dsum, dd = fmaxf(fabsf(dn), emr[tl]), inv = 1.0f / dd;
        if (tok >= 0) {
#pragma unroll
          for (int e2 = 0; e2 < 2; ++e2) Z[(size_t)(b * T + tok) * LDZE + 1024 + hh * 256 + s2 * 64 + 16 * (2 * eh + e2) + fr] = f2bf((wi * inter[e2][r] + intra[e2][r]) * inv);
        }
      }
    }
    { const float sc = scal[0];
#pragma unroll
      for (int et = 0; et < 4; ++et) {
        f32x4 a = Cacc[et] * sc;
#pragma unroll
        for (int ks = 0; ks < 2; ++ks) { const bf16x8 ak = *(const bf16x8*)(Kt + (16 * w + fr) * 72 + 32 * ks + 8 * fq); const bf16x8 vb = *(const bf16x8*)(Vt + (16 * et + fr) * 72 + 32 * ks + 8 * fq); a = MFMA(ak, vb, a); }
        Cacc[et] = a;
      }
      if (tid >= 384) { const int d = tid - 384; float sacc = 0.f;
#pragma unroll
        for (int j = 0; j < 8; ++j) { const uint4 kv = *(const uint4*)(Kt + d * 72 + j * 8); sacc += bf_lo(kv.x) + bf_hi(kv.x) + bf_lo(kv.y) + bf_hi(kv.y) + bf_lo(kv.z) + bf_hi(kv.z) + bf_lo(kv.w) + bf_hi(kv.w); }
        nv[d] = sc * nv[d] + sacc; }
    }
    LBAR();
  }
}

__device__ __forceinline__ void rglru_item(const Params& p, unsigned char* lds, int item, const int tid, unsigned* hcnt, unsigned& hgen) {
  const int w = tid >> 6, lane = tid & 63, fr = lane & 15, fq = lane >> 4;
  const int q4 = item & 3, g = (item >> 2) & 7, b = item >> 5;
  bf16_t* Z = (bf16_t*)(p.ws + OFF_Z);
  bf16_t* raw = (bf16_t*)lds;
  bf16_t* xcA = raw + 67 * 136;
  float* xcF = (float*)(xcA + 64 * 136);
  float* aS = xcF + 2112;
  float* uS = aS + 2112;
  float* cw = uS + 2112;
  float* segP = cw + 640;
  float* segL = segP + 256;
  float* hst = segL + 256;
  HBAR();
  for (int i = tid; i < 640; i += 256) { const int k = i >> 7, c = i & 127; cw[i] = k < 4 ? p.ev_conv_w[k * 1024 + g * 128 + c] : p.ev_conv_b[g * 128 + c]; }
  if (tid < 204) ((unsigned*)raw)[tid] = 0u;
  if (tid < 64) hst[tid] = 0.f;
  const bf16_t* WA = (const bf16_t*)(p.ws + OFF_WRA) + (size_t)g * 16384;
  const bf16_t* WX = (const bf16_t*)(p.ws + OFF_WRX) + (size_t)g * 16384;
  bf16x8 wa[2][4], wx[2][4]; float ba[2], bx[2], sp[2];
#pragma unroll
  for (int nt = 0; nt < 2; ++nt) {
    const int jc = q4 * 32 + 16 * nt + fr, cgi = g * 128 + jc;
#pragma unroll
    for (int kk = 0; kk < 4; ++kk) { wa[nt][kk] = *(const bf16x8*)(WA + jc * 128 + 32 * kk + 8 * fq); wx[nt][kk] = *(const bf16x8*)(WX + jc * 128 + 32 * kk + 8 * fq); }
    ba[nt] = p.ev_b_ra[cgi]; bx[nt] = p.ev_b_rx[cgi]; sp[nt] = log1pf(__expf(-p.ev_lam[cgi]));
  }
  const int prow = tid >> 4, pch = tid & 15;
  uint4 rx[4];
  auto prefetch = [&](int ti) {
#pragma unroll
    for (int i = 0; i < 4; ++i) { const int t = 64 * ti + prow + 16 * i;
      if (t < T) rx[i] = *(const uint4*)(Z + (size_t)(b * T + t) * LDZE + 2048 + g * 128 + pch * 8); else rx[i] = make_uint4(0, 0, 0, 0); }
  };
  prefetch(0);
  int cur = 0;
  for (int ti = 0; ti < 65; ++ti) {
    HBAR();
#pragma unroll
    for (int i = 0; i < 4; ++i) *(uint4*)(raw + (3 + prow + 16 * i) * 136 + pch * 8) = rx[i];
    HBAR();
    {
      const int tr = tid >> 2, cp = tid & 3;
#pragma unroll
      for (int c8 = 0; c8 < 4; ++c8) {
        const int c0 = cp * 32 + c8 * 8; float o[8];
#pragma unroll
        for (int j = 0; j < 8; ++j) o[j] = cw[512 + c0 + j];
#pragma unroll
        for (int k = 0; k < 4; ++k) { const uint4 xv = *(const uint4*)(raw + (tr + k) * 136 + c0); const float* wp = cw + k * 128 + c0;
          o[0] += wp[0] * bf_lo(xv.x); o[1] += wp[1] * bf_hi(xv.x); o[2] += wp[2] * bf_lo(xv.y); o[3] += wp[3] * bf_hi(xv.y);
          o[4] += wp[4] * bf_lo(xv.z); o[5] += wp[5] * bf_hi(xv.z); o[6] += wp[6] * bf_lo(xv.w); o[7] += wp[7] * bf_hi(xv.w); }
        *(uint4*)(xcA + tr * 136 + c0) = make_uint4(pk_bf16(o[0], o[1]), pk_bf16(o[2], o[3]), pk_bf16(o[4], o[5]), pk_bf16(o[6], o[7]));
        if (cp == q4) {
#pragma unroll
          for (int j = 0; j < 8; ++j) xcF[tr * 33 + c8 * 8 + j] = o[j]; }
      }
    }
    HBAR();
    if (tid < 192) ((unsigned*)raw)[(tid >> 6) * 68 + (tid & 63)] = ((unsigned*)raw)[(64 + (tid >> 6)) * 68 + (tid & 63)];
    if (ti + 1 < 65) prefetch(ti + 1);
    bf16_t gbv[8];
    { const int j = tid & 31, seg = tid >> 5;
#pragma unroll
      for (int k = 0; k < 8; ++k) { const int t = 64 * ti + 8 * seg + k; gbv[k] = t < T ? Z[(size_t)(b * T + t) * LDZE + 4096 + g * 128 + q4 * 32 + j] : (bf16_t)0; } }
    {
      f32x4 R[2], I[2];
#pragma unroll
      for (int nt = 0; nt < 2; ++nt) { R[nt] = (f32x4){0.f, 0.f, 0.f, 0.f}; I[nt] = (f32x4){0.f, 0.f, 0.f, 0.f}; }
#pragma unroll
      for (int kk = 0; kk < 4; ++kk) { const bf16x8 ax = *(const bf16x8*)(xcA + (16 * w + fr) * 136 + 32 * kk + 8 * fq);
#pragma unroll
        for (int nt = 0; nt < 2; ++nt) { R[nt] = MFMA(ax, wa[nt][kk], R[nt]); I[nt] = MFMA(ax, wx[nt][kk], I[nt]); } }
#pragma unroll
      for (int nt = 0; nt < 2; ++nt)
#pragma unroll
        for (int r = 0; r < 4; ++r) {
          const int t = 16 * w + 4 * fq + r, jl = 16 * nt + fr;
          const float rg = sigmoidf_(R[nt][r] + ba[nt]), ig = sigmoidf_(I[nt][r] + bx[nt]);
          const float la = -8.0f * rg * sp[nt];
          aS[t * 33 + jl] = __builtin_amdgcn_exp2f(la * LOG2E);
          const float x2 = 2.0f * la, om = x2 > -0.25f ? neg_expm1_small(x2) : 1.0f - __builtin_amdgcn_exp2f(x2 * LOG2E);
          uS[t * 33 + jl] = __builtin_amdgcn_sqrtf(om) * (ig * xcF[t * 33 + jl]);
        }
    }
    HBAR();
    const int j = tid & 31, seg = tid >> 5;
    float Lk[8], Pk[8];
    { float P = 1.f, L = 0.f;
#pragma unroll
      for (int k = 0; k < 8; ++k) { const float a = aS[(8 * seg + k) * 33 + j], u = uS[(8 * seg + k) * 33 + j]; L = a * L + u; P = a * P; Lk[k] = L; Pk[k] = P; }
      segP[seg * 32 + j] = P; segL[seg * 32 + j] = L; }
    HBAR();
    { float hin = hst[cur * 32 + j];
#pragma unroll
      for (int s = 0; s < 7; ++s) if (s < seg) hin = segP[s * 32 + j] * hin + segL[s * 32 + j];
#pragma unroll
      for (int k = 0; k < 8; ++k) {
        const float hv = Lk[k] + Pk[k] * hin; const int t = 64 * ti + 8 * seg + k;
        if (k == 7 && seg == 7) hst[(cur ^ 1) * 32 + j] = hv;
        if (t < T) { bf16_t* gp = Z + (size_t)(b * T + t) * LDZE + 4096 + g * 128 + q4 * 32 + j; const float x = bf2f(gbv[k]);
          const float ge = x * sigmoidf_(1.5957691216057308f * (x + 0.044715f * x * x * x)); *gp = f2bf(hv * ge); }
      }
    }
    cur ^= 1;
  }
}

__device__ __forceinline__ void rglru_item8(const Params& p, unsigned char* lds, int item) {
  const int tid = otid(), w = __builtin_amdgcn_readfirstlane(tid >> 6), lane = tid & 63, fr = lane & 15, fq = lane >> 4;
  const int h2 = item & 1, g = (item >> 1) & 7, b = item >> 4;
  bf16_t* Z = (bf16_t*)(p.ws + OFF_Z);
  bf16_t* raw = (bf16_t*)lds;
  bf16_t* xcA = raw + 67 * 136;
  float* xcF = (float*)(xcA + 64 * 136);
  float* aS = xcF + 64 * 65;
  float* uS = aS + 64 * 65;
  float* cw = uS + 64 * 65;
  float* segP = cw + 640;
  float* segL = segP + 512;
  float* hst = segL + 512;
  LBAR();
  for (int i = tid; i < 640; i += NT) { const int k = i >> 7, c = i & 127; cw[i] = k < 4 ? p.ev_conv_w[k * 1024 + g * 128 + c] : p.ev_conv_b[g * 128 + c]; }
  if (tid < 204) ((unsigned*)raw)[tid] = 0u;
  if (tid < 128) hst[tid] = 0.f;
  const int tt = w & 3, jh = w >> 2;
  const bf16_t* WA = (const bf16_t*)(p.ws + OFF_WRA) + (size_t)g * 16384;
  const bf16_t* WX = (const bf16_t*)(p.ws + OFF_WRX) + (size_t)g * 16384;
  bf16x8 wa[2][4], wx[2][4]; float ba[2], bx[2], sp[2];
#pragma unroll
  for (int nt = 0; nt < 2; ++nt) {
    const int jc = h2 * 64 + jh * 32 + 16 * nt + fr, cgi = g * 128 + jc;
#pragma unroll
    for (int kk = 0; kk < 4; ++kk) { wa[nt][kk] = *(const bf16x8*)(WA + jc * 128 + 32 * kk + 8 * fq); wx[nt][kk] = *(const bf16x8*)(WX + jc * 128 + 32 * kk + 8 * fq); }
    ba[nt] = p.ev_b_ra[cgi]; bx[nt] = p.ev_b_rx[cgi]; sp[nt] = log1pf(__expf(-p.ev_lam[cgi]));
  }
  const int prow = tid >> 4, pch = tid & 15;
  uint4 rxA[2], rxB[2]; bf16_t gbA[8], gbB[8];
  auto prefetch = [&](int ti, uint4 (&rx)[2]) {
#pragma unroll
    for (int i = 0; i < 2; ++i) { const int t = 64 * ti + prow + 32 * i;
      if (t < T) rx[i] = *(const uint4*)(Z + (size_t)(b * T + t) * LDZE + 2048 + g * 128 + pch * 8); else rx[i] = make_uint4(0, 0, 0, 0); }
  };
  auto loadgb = [&](int ti, bf16_t (&gbv)[8]) {
#pragma unroll
    for (int k = 0; k < 8; ++k) { const int t = 64 * ti + 8 * w + k; gbv[k] = t < T ? Z[(size_t)(b * T + t) * LDZE + 4096 + g * 128 + h2 * 64 + lane] : (bf16_t)0; }
  };
  prefetch(0, rxA); prefetch(1, rxB); loadgb(0, gbA); loadgb(1, gbB);
  int cur = 0;
  auto tile_step = [&](const int ti, uint4 (&rx)[2], bf16_t (&gbv)[8]) {
    LBAR();
#pragma unroll
    for (int i = 0; i < 2; ++i) *(uint4*)(raw + (3 + prow + 32 * i) * 136 + pch * 8) = rx[i];
    LBAR();
    {
      const int tr = tid >> 3, cp = tid & 7;
#pragma unroll
      for (int c8 = 0; c8 < 2; ++c8) {
        const int c0 = cp * 16 + c8 * 8; float o[8];
#pragma unroll
        for (int j = 0; j < 8; ++j) o[j] = cw[512 + c0 + j];
#pragma unroll
        for (int k = 0; k < 4; ++k) { const uint4 xv = *(const uint4*)(raw + (tr + k) * 136 + c0); const float* wp = cw + k * 128 + c0;
          o[0] += wp[0] * bf_lo(xv.x); o[1] += wp[1] * bf_hi(xv.x); o[2] += wp[2] * bf_lo(xv.y); o[3] += wp[3] * bf_hi(xv.y);
          o[4] += wp[4] * bf_lo(xv.z); o[5] += wp[5] * bf_hi(xv.z); o[6] += wp[6] * bf_lo(xv.w); o[7] += wp[7] * bf_hi(xv.w); }
        *(uint4*)(xcA + tr * 136 + c0) = make_uint4(pk_bf16(o[0], o[1]), pk_bf16(o[2], o[3]), pk_bf16(o[4], o[5]), pk_bf16(o[6], o[7]));
        if ((cp >> 2) == h2) {
#pragma unroll
          for (int j = 0; j < 8; ++j) xcF[tr * 65 + (c0 - 64 * h2) + j] = o[j]; }
      }
    }
    LBAR();
    if (tid < 192) ((unsigned*)raw)[(tid >> 6) * 68 + (tid & 63)] = ((unsigned*)raw)[(64 + (tid >> 6)) * 68 + (tid & 63)];
    if (ti + 2 < 65) prefetch(ti + 2, rx);
    {
      f32x4 R[2], I[2];
#pragma unroll
      for (int nt = 0; nt < 2; ++nt) { R[nt] = (f32x4){0.f, 0.f, 0.f, 0.f}; I[nt] = (f32x4){0.f, 0.f, 0.f, 0.f}; }
#pragma unroll
      for (int kk = 0; kk < 4; ++kk) { const bf16x8 ax = *(const bf16x8*)(xcA + (16 * tt + fr) * 136 + 32 * kk + 8 * fq);
#pragma unroll
        for (int nt = 0; nt < 2; ++nt) { R[nt] = MFMA(ax, wa[nt][kk], R[nt]); I[nt] = MFMA(ax, wx[nt][kk], I[nt]); } }
#pragma unroll
      for (int nt = 0; nt < 2; ++nt)
#pragma unroll
        for (int r = 0; r < 4; ++r) {
          const int t = 16 * tt + 4 * fq + r, jl = jh * 32 + 16 * nt + fr;
          const float rg = sigmoidf_(R[nt][r] + ba[nt]), ig = sigmoidf_(I[nt][r] + bx[nt]);
          const float la = -8.0f * rg * sp[nt];
          aS[t * 65 + jl] = __builtin_amdgcn_exp2f(la * LOG2E);
          const float x2 = 2.0f * la, om = x2 > -0.25f ? neg_expm1_small(x2) : 1.0f - __builtin_amdgcn_exp2f(x2 * LOG2E);
          uS[t * 65 + jl] = __builtin_amdgcn_sqrtf(om) * (ig * xcF[t * 65 + jl]);
        }
    }
    LBAR();
    const int j = lane, seg = w;
    float Lk[8], Pk[8];
    { float P = 1.f, L = 0.f;
#pragma unroll
      for (int k = 0; k < 8; ++k) { const float a = aS[(8 * seg + k) * 65 + j], u = uS[(8 * seg + k) * 65 + j]; L = a * L + u; P = a * P; Lk[k] = L; Pk[k] = P; }
      segP[seg * 64 + j] = P; segL[seg * 64 + j] = L; }
    LBAR();
    { float hin = hst[cur * 64 + j];
#pragma unroll
      for (int sI = 0; sI < 7; ++sI) if (sI < seg) hin = segP[sI * 64 + j] * hin + segL[sI * 64 + j];
#pragma unroll
      for (int k = 0; k < 8; ++k) {
        const float hv = Lk[k] + Pk[k] * hin; const int t = 64 * ti + 8 * seg + k;
        if (k == 7 && seg == 7) hst[(cur ^ 1) * 64 + j] = hv;
        if (t < T) { bf16_t* gp = Z + (size_t)(b * T + t) * LDZE + 4096 + g * 128 + h2 * 64 + j; const float x = bf2f(gbv[k]);
          const float ge = x * sigmoidf_(1.5957691216057308f * (x + 0.044715f * x * x * x)); *gp = f2bf(hv * ge); }
      }
    }
    if (ti + 2 < 65) loadgb(ti + 2, gbv);
    cur ^= 1;
  };
  for (int ti = 0; ti < 65; ti += 2) {
    tile_step(ti, rxA, gbA);
    if (ti + 1 < 65) tile_step(ti + 1, rxB, gbB);
  }
}

__device__ __forceinline__ void anorm_phase(const Params& p) {
  const int tid = otid(); const int lane = tid & 63, wave = (obid() * NT + tid) >> 6, nw = gridDim.x * (NT / 64);
  bf16_t* Z = (bf16_t*)(p.ws + OFF_Z);
  for (int r = wave; r < M; r += nw) {
    bf16_t* zr = Z + (size_t)r * LDZE;
    const uint4 h0 = *(const uint4*)(zr + 1024 + 16 * lane), h1 = *(const uint4*)(zr + 1024 + 16 * lane + 8);
    const uint4 o0 = *(const uint4*)(zr + 3072 + 16 * lane), o1 = *(const uint4*)(zr + 3072 + 16 * lane + 8);
    const unsigned hu[8] = {h0.x, h0.y, h0.z, h0.w, h1.x, h1.y, h1.z, h1.w}, ou[8] = {o0.x, o0.y, o0.z, o0.w, o1.x, o1.y, o1.z, o1.w};
    float hv[16], ov[16]; float ss = 0.f;
#pragma unroll
    for (int i = 0; i < 8; ++i) { hv[2 * i] = bf_lo(hu[i]); hv[2 * i + 1] = bf_hi(hu[i]); ov[2 * i] = bf_lo(ou[i]); ov[2 * i + 1] = bf_hi(ou[i]); ss += hv[2 * i] * hv[2 * i] + hv[2 * i + 1] * hv[2 * i + 1]; }
    ss += __shfl_xor(ss, 1); ss += __shfl_xor(ss, 2); ss += __shfl_xor(ss, 4); ss += __shfl_xor(ss, 8);
    const float rs = rsqrtf(ss * (1.0f / 256.0f) + EPS);
    const float* gp = p.ev_a_norm + ((16 * lane) & 255);
    unsigned res[8];
#pragma unroll
    for (int i = 0; i < 8; ++i) res[i] = pk_bf16(hv[2 * i] * rs * gp[2 * i] * sigmoidf_(ov[2 * i]), hv[2 * i + 1] * rs * gp[2 * i + 1] * sigmoidf_(ov[2 * i + 1]));
    *(uint4*)(zr + 3072 + 16 * lane) = make_uint4(res[0], res[1], res[2], res[3]);
    *(uint4*)(zr + 3072 + 16 * lane + 8) = make_uint4(res[4], res[5], res[6], res[7]);
  }
}

__device__ __forceinline__ void oddprep_phase(const Params& p) {
  const int tid = otid(); const int lane = tid & 63, wave = (obid() * NT + tid) >> 6, nw = gridDim.x * (NT / 64);
  bf16_t* Zo = (bf16_t*)(p.ws + OFF_Z);
  float* G = (float*)(p.ws + OFF_GATES);
  bf16_t* KR = (bf16_t*)(p.ws + OFF_KR);
  float* ROPE = (float*)(p.ws + OFF_ROPE);
  for (int r = wave; r < M; r += nw) {
    bf16_t* zr = Zo + (size_t)r * LDZO;
    {
      unsigned u[3]; float ss = 0.f;
#pragma unroll
      for (int j = 0; j < 3; ++j) { u[j] = *(const unsigned*)(zr + 128 * j + 2 * lane); ss += bf_lo(u[j]) * bf_lo(u[j]) + bf_hi(u[j]) * bf_hi(u[j]); }
      ss = wave_sum(ss); const float rs = rsqrtf(ss * (1.0f / 384.0f) + EPS);
#pragma unroll
      for (int j = 0; j < 3; ++j) { const float* gp = p.od_g_qa + 128 * j + 2 * lane; *(unsigned*)(zr + 128 * j + 2 * lane) = pk_bf16(bf_lo(u[j]) * rs * gp[0], bf_hi(u[j]) * rs * gp[1]); }
    }
    {
      const uint2 u = *(const uint2*)(zr + 384 + 4 * lane);
      float v0 = bf_lo(u.x), v1 = bf_hi(u.x), v2 = bf_lo(u.y), v3 = bf_hi(u.y);
      float ss = wave_sum(v0 * v0 + v1 * v1 + v2 * v2 + v3 * v3); const float rs = rsqrtf(ss * (1.0f / 256.0f) + EPS);
      const float* gp = p.od_g_kva + 4 * lane; uint2 o; o.x = pk_bf16(v0 * rs * gp[0], v1 * rs * gp[1]); o.y = pk_bf16(v2 * rs * gp[2], v3 * rs * gp[3]);
      *(uint2*)(zr + 384 + 4 * lane) = o;
    }
    {
      const int b = r / T, t = r - b * T;
      const int pos = t < 16 ? t : p.pos[b * 4096 + (t - 16)] + 16;
      const int i = lane & 15;
      const float freq = exp2f(-(float)i * 0.8304820237218406f);
      const float ang = (float)pos * freq;
      double rev = (double)ang * 0.15915494309189535; rev -= rint(rev);
      const float rf = (float)rev;
      const float cs = __builtin_amdgcn_cosf(rf), sn = __builtin_amdgcn_sinf(rf);
      float v = lane < 32 ? bf2f(zr[640 + lane]) : 0.f;
      const float ss = wave_sum(v * v); const float rs = rsqrtf(ss * (1.0f / 32.0f) + EPS);
      const float kn = lane < 32 ? v * rs * p.od_g_kr[lane & 31] : 0.f;
      const float pt = __shfl_xor(kn, 16);
      const float o = lane < 16 ? kn * cs - pt * sn : pt * sn + kn * cs;
      if (lane < 32) KR[(size_t)r * 32 + lane] = f2bf(o);
      if (lane < 16) { ROPE[(size_t)r * 32 + lane] = cs; ROPE[(size_t)r * 32 + 16 + lane] = sn; }
    }
#pragma unroll
    for (int which = 0; which < 2; ++which) {
      bf16_t* base = zr + (which ? 1184 : 672) + 8 * lane; const float* gg = (which ? p.od_g_fk : p.od_g_fq) + 8 * (lane & 7);
      const uint4 u = *(const uint4*)base; const unsigned uu[4] = {u.x, u.y, u.z, u.w};
      float v[8]; float ss = 0.f;
#pragma unroll
      for (int j = 0; j < 4; ++j) { v[2 * j] = bf_lo(uu[j]); v[2 * j + 1] = bf_hi(uu[j]); ss += v[2 * j] * v[2 * j] + v[2 * j + 1] * v[2 * j + 1]; }
      ss += __shfl_xor(ss, 1); ss += __shfl_xor(ss, 2); ss += __shfl_xor(ss, 4);
      const float rs = rsqrtf(ss * (1.0f / 64.0f) + EPS);
      *(uint4*)base = make_uint4(pk_bf16(v[0] * rs * gg[0], v[1] * rs * gg[1]), pk_bf16(v[2] * rs * gg[2], v[3] * rs * gg[3]), pk_bf16(v[4] * rs * gg[4], v[5] * rs * gg[5]), pk_bf16(v[6] * rs * gg[6], v[7] * rs * gg[7]));
    }
    if (lane < 8) { float* gp = G + (size_t)r * 8 + lane; *gp = logsigmoidf_(*gp + p.od_b_f[lane]); }
  }
}

__device__ __forceinline__ void fcum_item(const Params& p, unsigned char* lds, int item) {
  const int tid = otid(), b = item >> 3, hh = item & 7;
  const float* G = (const float*)(p.ws + OFF_GATES);
  float* FC = (float*)(p.ws + OFF_FCUM) + (size_t)item * T;
  float* part = (float*)lds;
  float loc[9]; float s = 0.f;
#pragma unroll
  for (int k = 0; k < 9; ++k) { const int t = tid * 9 + k; loc[k] = t < T ? G[(size_t)(b * T + t) * 8 + hh] : 0.f; s += loc[k]; }
  __syncthreads();
  part[tid] = s;
  __syncthreads();
  float pre = 0.f;
  for (int i = 0; i < tid; ++i) pre += part[i];
#pragma unroll
  for (int k = 0; k < 9; ++k) { const int t = tid * 9 + k; pre += loc[k]; if (t < T) FC[t] = pre; }
  __syncthreads();
}

__device__ __forceinline__ void headprep_phase(const Params& p) {
  bf16_t* QR = (bf16_t*)(p.ws + OFF_QRAW); bf16_t* KV = (bf16_t*)(p.ws + OFF_KVRAW);
  const float* ROPE = (const float*)(p.ws + OFF_ROPE);
  const int gt = obid() * NT + otid(), nth = gridDim.x * NT;
  for (int idx = gt; idx < M * 8; idx += nth) {
    const int r = idx >> 3, hh = idx & 7;
    { bf16_t* qp = QR + (size_t)r * 768 + hh * 96;
      float v[96]; float s1 = 0.f, s2 = 0.f;
#pragma unroll
      for (int c = 0; c < 12; ++c) { const uint4 u = *(const uint4*)(qp + 8 * c); const unsigned uu[4] = {u.x, u.y, u.z, u.w};
#pragma unroll
        for (int j = 0; j < 4; ++j) { v[8 * c + 2 * j] = bf_lo(uu[j]); v[8 * c + 2 * j + 1] = bf_hi(uu[j]); } }
#pragma unroll
      for (int i = 0; i < 64; ++i) s1 += v[i] * v[i];
#pragma unroll
      for (int i = 64; i < 96; ++i) s2 += v[i] * v[i];
      const float r1 = rsqrtf(s1 * (1.0f / 64.0f) + EPS), r2 = rsqrtf(s2 * (1.0f / 32.0f) + EPS);
#pragma unroll
      for (int i = 0; i < 64; ++i) v[i] = v[i] * r1 * p.od_g_qn[i];
#pragma unroll
      for (int i = 0; i < 32; ++i) v[64 + i] = v[64 + i] * r2 * p.od_g_qr[i];
#pragma unroll
      for (int i = 0; i < 16; ++i) { const float cs = ROPE[(size_t)r * 32 + i], sn = ROPE[(size_t)r * 32 + 16 + i]; const float x1 = v[64 + i], x2 = v[80 + i]; v[64 + i] = x1 * cs - x2 * sn; v[80 + i] = x1 * sn + x2 * cs; }
#pragma unroll
      for (int c = 0; c < 12; ++c) *(uint4*)(qp + 8 * c) = make_uint4(pk_bf16(v[8 * c], v[8 * c + 1]), pk_bf16(v[8 * c + 2], v[8 * c + 3]), pk_bf16(v[8 * c + 4], v[8 * c + 5]), pk_bf16(v[8 * c + 6], v[8 * c + 7]));
    }
    { bf16_t* kp = KV + (size_t)r * 1024 + hh * 128;
      float v[64]; float s1 = 0.f;
#pragma unroll
      for (int c = 0; c < 8; ++c) { const uint4 u = *(const uint4*)(kp + 8 * c); const unsigned uu[4] = {u.x, u.y, u.z, u.w};
#pragma unroll
        for (int j = 0; j < 4; ++j) { v[8 * c + 2 * j] = bf_lo(uu[j]); v[8 * c + 2 * j + 1] = bf_hi(uu[j]); } }
#pragma unroll
      for (int i = 0; i < 64; ++i) s1 += v[i] * v[i];
      const float r1 = rsqrtf(s1 * (1.0f / 64.0f) + EPS);
#pragma unroll
      for (int i = 0; i < 64; ++i) v[i] = v[i] * r1 * p.od_g_kn[i];
#pragma unroll
      for (int c = 0; c < 8; ++c) *(uint4*)(kp + 8 * c) = make_uint4(pk_bf16(v[8 * c], v[8 * c + 1]), pk_bf16(v[8 * c + 2], v[8 * c + 3]), pk_bf16(v[8 * c + 4], v[8 * c + 5]), pk_bf16(v[8 * c + 6], v[8 * c + 7]));
    }
  }
}

#define XB_TMO      128
#define XB_XCNT(j)  (256  + 64 * (j))
#define XB_XSUB(j)  (1280 + 64 * (j))
#define XB_XGEN(j)  (2304 + 64 * (j))
#define XB_TOP      3328
#define XB_TOPGEN   3392
#define XCD_BAR_WORDS 3456
#define XB_SPIN_CAP (1u << 18)
#define LAS __attribute__((address_space(3)))

__device__ __forceinline__ unsigned xb_ld(unsigned* p)              { return __hip_atomic_load(p, __ATOMIC_RELAXED, __HIP_MEMORY_SCOPE_AGENT); }
__device__ __forceinline__ unsigned xb_add(unsigned* p, unsigned v) { return __hip_atomic_fetch_add(p, v, __ATOMIC_RELAXED, __HIP_MEMORY_SCOPE_AGENT); }
__device__ __forceinline__ unsigned xb_xcc_id() { return (unsigned)__builtin_amdgcn_s_getreg((3 << 11) | 20) & 0xFu; }
#define XB_SPIN(cond, bar) do { unsigned _sp = 0; while (cond) { __builtin_amdgcn_s_sleep(1); \
    if ((++_sp & 255u) == 0u) { if (xb_ld(&(bar)[XB_TMO])) break; if (_sp > XB_SPIN_CAP) { atomicAdd(&(bar)[XB_TMO], 1u); break; } } } } while (0)

struct XcdBarrier {
    unsigned* bar; unsigned x;
    volatile LAS unsigned* st;
};

__device__ __forceinline__ XcdBarrier xcd_barrier_post(unsigned* bar, volatile LAS unsigned* st) {
    XcdBarrier b; b.bar = bar; b.x = xb_xcc_id(); b.st = st;
    if (threadIdx.x == 0) (void)xb_add(&bar[XB_XCNT(b.x)], 1u);
    return b;
}
__device__ __forceinline__ void xcd_barrier_complete(unsigned* bar, unsigned x, unsigned& nloc, unsigned& nx) {
    const unsigned G = gridDim.x * gridDim.y * gridDim.z;
    unsigned sum, cnt, mine, sp = 0u;
    for (;;) {
        sum = 0u; cnt = 0u; mine = 0u;
#pragma unroll
        for (unsigned j = 0; j < 16; ++j) { const unsigned c = xb_ld(&bar[XB_XCNT(j)]); sum += c; cnt += (c > 0u) ? 1u : 0u; mine = (j == x) ? c : mine; }
        if (sum == G) break;
        __builtin_amdgcn_s_sleep(1);
        if ((++sp & 255u) == 0u) { if (xb_ld(&bar[XB_TMO])) break; if (sp > XB_SPIN_CAP) { atomicAdd(&bar[XB_TMO], 1u); break; } }
    }
    nloc = mine > 0u ? mine : 1u; nx = cnt > 0u ? cnt : 1u;
}

__device__ __forceinline__ void xcd_barrier(const XcdBarrier& b) {
    asm volatile("s_waitcnt vmcnt(0)" ::: "memory");
    __syncthreads();
    if (threadIdx.x == 0) {
        unsigned* bar = b.bar;
        __builtin_amdgcn_s_waitcnt(0);
        unsigned nloc = b.st[0], nx = b.st[1];
        if (nloc == 0u) { xcd_barrier_complete(bar, b.x, nloc, nx); b.st[0] = nloc; b.st[1] = nx; }
        const unsigned old = xb_add(&bar[XB_XSUB(b.x)], 1u);
        const unsigned gen = old / nloc;
        if (old + 1u == (gen + 1u) * nloc) {
            __builtin_amdgcn_fence(__ATOMIC_RELEASE, "agent");
            asm volatile("s_waitcnt vmcnt(0)" ::: "memory");
            const unsigned og = xb_add(&bar[XB_TOP], 1u);
            const unsigned tg = og / nx;
            if (og + 1u == (tg + 1u) * nx) xb_add(&bar[XB_TOPGEN], 1u);
            else XB_SPIN(xb_ld(&bar[XB_TOPGEN]) == tg, bar);
            __builtin_amdgcn_fence(__ATOMIC_ACQUIRE, "agent");
            xb_add(&bar[XB_XGEN(b.x)], 1u);
            asm volatile("s_waitcnt vmcnt(0)" ::: "memory");
        } else {
            XB_SPIN(xb_ld(&bar[XB_XGEN(b.x)]) == gen, bar);
            __builtin_amdgcn_fence(__ATOMIC_ACQUIRE, "agent");
            asm volatile("s_waitcnt vmcnt(0)" ::: "memory");
        }
    }
    __syncthreads();
}

template <int DK, bool BIAS>
__device__ __forceinline__ void attn_item(unsigned char* lds, const bf16_t* __restrict__ Qp, int ldq, const bf16_t* __restrict__ Kp, int ldk, const bf16_t* __restrict__ K2p, int ldk2,
                          const bf16_t* __restrict__ Vp, int ldv, const float* __restrict__ fc, bf16_t* __restrict__ Op, int b, int q0, int qend, int nkv, float scale) {
  constexpr int KS = DK / 32, KST = DK + 8, NCH = DK / 8, NPIECE = 64 * NCH;
  const int tid = otid(), w = tid >> 6, lane = tid & 63, fr = lane & 15, fq = lane >> 4;
  bf16_t* Ksm = (bf16_t*)lds;
  bf16_t* Vtm = Ksm + 2 * 64 * KST;
  float* fkm = (float*)(Vtm + 2 * 64 * 72);
  const int rowb = b * T;
  const bool wact = q0 + 32 * w < qend;
  bf16x8 qf[2][KS];
#pragma unroll
  for (int qi = 0; qi < 2; ++qi) {
    const int qg = q0 + 32 * w + 16 * qi + fr;
#pragma unroll
    for (int ks = 0; ks < KS; ++ks) { uint4 u = make_uint4(0, 0, 0, 0); if (qg < qend) u = *(const uint4*)(Qp + (size_t)(rowb + qg) * ldq + 32 * ks + 8 * fq); qf[qi][ks] = mk8u(u); }
  }
  f32x4 O[4][2];
#pragma unroll
  for (int et = 0; et < 4; ++et)
#pragma unroll
    for (int qi = 0; qi < 2; ++qi) O[et][qi] = (f32x4){0.f, 0.f, 0.f, 0.f};
  float mrun[2] = {-1e30f, -1e30f}, lrun[2] = {0.f, 0.f};
  uint4 rk0A, rk1A = make_uint4(0, 0, 0, 0), rvA, rk0B = make_uint4(0, 0, 0, 0), rk1B = make_uint4(0, 0, 0, 0), rvB = make_uint4(0, 0, 0, 0); float rfkA = 0.f, rfkB = 0.f;
  const int krow0 = tid / NCH, kch0 = tid - krow0 * NCH, krow1 = (tid + 512) / NCH, kch1 = (tid + 512) - krow1 * NCH;
  const int vrow = tid & 63, vch = tid >> 6;
  auto kload = [&](int kg, int chn) -> uint4 {
    uint4 u = make_uint4(0, 0, 0, 0);
    if (kg < T) { if (DK == 64 || chn < 8) u = *(const uint4*)(Kp + (size_t)(rowb + kg) * ldk + chn * 8); else u = *(const uint4*)(K2p + (size_t)(rowb + kg) * ldk2 + (chn - 8) * 8); }
    return u; };
  auto prefetch = [&](int j, uint4& rk0, uint4& rk1, uint4& rv, float& rfk) {
    rk0 = kload(64 * j + krow0, kch0);
    if (NPIECE > 512 && tid + 512 < NPIECE) rk1 = kload(64 * j + krow1, kch1);
    { const int kg = 64 * j + vrow; rv = make_uint4(0, 0, 0, 0); if (kg < T) rv = *(const uint4*)(Vp + (size_t)(rowb + kg) * ldv + vch * 8); }
    if (BIAS && tid < 64) { const int kg = 64 * j + tid; rfk = kg < T ? -fc[kg] * LOG2E : 0.f; }
  };
  auto stage = [&](int buf, const uint4& rk0, const uint4& rk1, const uint4& rv, const float& rfk) {
    *(uint4*)(Ksm + (buf * 64 + krow0) * KST + kch0 * 8) = rk0;
    if (NPIECE > 512 && tid + 512 < NPIECE) *(uint4*)(Ksm + (buf * 64 + krow1) * KST + kch1 * 8) = rk1;
    { const unsigned vv[4] = {rv.x, rv.y, rv.z, rv.w};
#pragma unroll
      for (int jj = 0; jj < 4; ++jj) { Vtm[(buf * 64 + vch * 8 + 2 * jj) * 72 + vrow] = (bf16_t)(vv[jj] & 0xffffu); Vtm[(buf * 64 + vch * 8 + 2 * jj + 1) * 72 + vrow] = (bf16_t)(vv[jj] >> 16); } }
    if (BIAS && tid < 64) fkm[buf * 64 + tid] = rfk;
  };
  __syncthreads();
  prefetch(0, rk0A, rk1A, rvA, rfkA); stage(0, rk0A, rk1A, rvA, rfkA);
  if (nkv > 1) prefetch(1, rk0B, rk1B, rvB, rfkB);
  __syncthreads();
  const float sc2 = scale * LOG2E;
  auto tile_step = [&](const int j, uint4& pk0, uint4& pk1, uint4& pv, float& pfk, const uint4& sk0, const uint4& sk1, const uint4& sv, const float& sfk) {
    const int buf = j & 1;
    if (j + 2 < nkv) prefetch(j + 2, pk0, pk1, pv, pfk);
    if (wact && 64 * j <= q0 + 32 * w + 31) {
      f32x4 S[4][2];
#pragma unroll
      for (int kt = 0; kt < 4; ++kt)
#pragma unroll
        for (int qi = 0; qi < 2; ++qi) S[kt][qi] = (f32x4){0.f, 0.f, 0.f, 0.f};
#pragma unroll
      for (int ks = 0; ks < KS; ++ks)
#pragma unroll
        for (int kt = 0; kt < 4; ++kt) { const bf16x8 ak = *(const bf16x8*)(Ksm + (buf * 64 + 16 * kt + fr) * KST + 32 * ks + 8 * fq);
#pragma unroll
          for (int qi = 0; qi < 2; ++qi) S[kt][qi] = MFMA(ak, qf[qi][ks], S[kt][qi]); }
      bf16x8 pf[2][2];
      if (64 * j + 63 > q0 + 32 * w) {
#pragma unroll
        for (int qi = 0; qi < 2; ++qi) { const int qg = q0 + 32 * w + 16 * qi + fr;
#pragma unroll
          for (int kt = 0; kt < 4; ++kt)
#pragma unroll
            for (int r = 0; r < 4; ++r) { const int kg = 64 * j + 16 * kt + 4 * fq + r; if (kg > qg) S[kt][qi][r] = -1e30f; } }
      }
#pragma unroll
      for (int qi = 0; qi < 2; ++qi) {
        float mx = -3e38f;
        if (BIAS) {
#pragma unroll
          for (int kt = 0; kt < 4; ++kt) { const f32x4 nf = *(const f32x4*)(fkm + buf * 64 + 16 * kt + 4 * fq);
#pragma unroll
            for (int r = 0; r < 4; ++r) { const float t = fmaf(S[kt][qi][r], sc2, nf[r]); S[kt][qi][r] = t; mx = fmaxf(mx, t); } }
        } else {
#pragma unroll
          for (int kt = 0; kt < 4; ++kt)
#pragma unroll
            for (int r = 0; r < 4; ++r) mx = fmaxf(mx, S[kt][qi][r]);
          mx *= sc2;
        }
        mx = fmaxf(mx, __shfl_xor(mx, 16)); mx = fmaxf(mx, __shfl_xor(mx, 32));
        const float mold = mrun[qi], mnew = fmaxf(mold, mx);
        mrun[qi] = mnew;
        float ps = 0.f;
#pragma unroll
        for (int kt = 0; kt < 4; ++kt)
#pragma unroll
          for (int r = 0; r < 4; ++r) { const float pv = BIAS ? __builtin_amdgcn_exp2f(S[kt][qi][r] - mnew) : __builtin_amdgcn_exp2f(fmaf(S[kt][qi][r], sc2, -mnew)); S[kt][qi][r] = pv; ps += pv; }
        {
          const float alpha = __builtin_amdgcn_exp2f(mold - mnew);
          lrun[qi] *= alpha;
#pragma unroll
          for (int et = 0; et < 4; ++et) O[et][qi] *= alpha;
        }
        lrun[qi] += ps;
#pragma unroll
        for (int k2 = 0; k2 < 2; ++k2) { uint2 lo, hi; lo.x = pk_bf16(S[2 * k2][qi][0], S[2 * k2][qi][1]); lo.y = pk_bf16(S[2 * k2][qi][2], S[2 * k2][qi][3]);
          hi.x = pk_bf16(S[2 * k2 + 1][qi][0], S[2 * k2 + 1][qi][1]); hi.y = pk_bf16(S[2 * k2 + 1][qi][2], S[2 * k2 + 1][qi][3]); pf[qi][k2] = mk8(lo, hi); }
      }
#pragma unroll
      for (int k2 = 0; k2 < 2; ++k2)
#pragma unroll
        for (int et = 0; et < 4; ++et) {
          const uint2 v0 = *(const uint2*)(Vtm + (buf * 64 + 16 * et + fr) * 72 + 32 * k2 + 4 * fq), v1 = *(const uint2*)(Vtm + (buf * 64 + 16 * et + fr) * 72 + 32 * k2 + 16 + 4 * fq);
          const bf16x8 va = mk8(v0, v1);
#pragma unroll
          for (int qi = 0; qi < 2; ++qi) O[et][qi] = MFMA(va, pf[qi][k2], O[et][qi]);
        }
    }
    if (j + 1 < nkv) stage(buf ^ 1, sk0, sk1, sv, sfk);
    LBAR();
  };
  for (int j = 0; j < nkv; j += 2) {
    tile_step(j, rk0A, rk1A, rvA, rfkA, rk0B, rk1B, rvB, rfkB);
    if (j + 1 < nkv) tile_step(j + 1, rk0B, rk1B, rvB, rfkB, rk0A, rk1A, rvA, rfkA);
  }
#pragma unroll
  for (int qi = 0; qi < 2; ++qi) {
    const int qg = q0 + 32 * w + 16 * qi + fr;
    float l = lrun[qi]; l += __shfl_xor(l, 16); l += __shfl_xor(l, 32);
    const float inv = 1.0f / l;
    if (qg < qend) {
#pragma unroll
      for (int et = 0; et < 4; ++et) { uint2 o; o.x = pk_bf16(O[et][qi][0] * inv, O[et][qi][1] * inv); o.y = pk_bf16(O[et][qi][2] * inv, O[et][qi][3] * inv);
        *(uint2*)(Op + (size_t)(rowb + qg) * 1024 + 16 * et + 4 * fq) = o; }
    }
  }
}

__device__ __forceinline__ void attn_phase(const Params& p, unsigned char* lds) {
  __shared__ int s_item;
  unsigned* ctr = (unsigned*)(p.ws + OFF_CTR);
  bf16_t* Zo = (bf16_t*)(p.ws + OFF_Z); bf16_t* QR = (bf16_t*)(p.ws + OFF_QRAW); bf16_t* KV = (bf16_t*)(p.ws + OFF_KVRAW);
  bf16_t* KR = (bf16_t*)(p.ws + OFF_KR); bf16_t* Y = (bf16_t*)(p.ws + OFF_XN);
  const float* FC = (const float*)(p.ws + OFF_FCUM);
  for (;;) {
    __syncthreads();
    if (otid() == 0) s_item = (int)atomicAdd(ctr, 1u);
    __syncthreads();
    const int it = s_item;
    if (it >= 17 * 128) break;
    const int k = 16 - it / 128, rem = it & 127, type = rem & 1, hh = (rem >> 1) & 7, b = rem >> 4;
    const int q0 = k ? 16 + 256 * (k - 1) : 0, qend = k ? q0 + 256 : 16, nkv = k ? 4 * k + 1 : 1;
    if (type == 0)
      attn_item<96, false>(lds, QR + hh * 96, 768, KV + hh * 128, 1024, KR, 32, KV + hh * 128 + 64, 1024, nullptr, Y + hh * 64, b, q0, qend, nkv, 0.10206207261596575f);
    else
      attn_item<64, true>(lds, Zo + 672 + hh * 64, LDZO, Zo + 1184 + hh * 64, LDZO, nullptr, 0, Zo + 1696 + hh * 64, LDZO, FC + (size_t)(b * 8 + hh) * T, Y + 512 + hh * 64, b, q0, qend, nkv, 0.125f);
  }
}

template <class Epi>
__device__ __forceinline__ void run_gemm(unsigned char* smem, const bf16_t* A, int lda, const bf16_t* Bt, int N, int K, const Epi& E) {
  pg8::Gemm g{A, Bt, MP, N, K, lda, K};
  pg8::StaticOrder S; S.init(MP, N, (int)gridDim.x, obid());
  pg8::gemm_phase<Epi, pg8::StaticOrder, true, true>((PG8_LAS unsigned char*)smem, g, S, E);
}

template <bool FIRST>
__device__ __forceinline__ void run_gemm_res(const Params& p, unsigned char* smem, const bf16_t* A, int lda, const bf16_t* Bt, int K) {
  { pg8::Gemm g{A, Bt, 32768, 1024, K, lda, K};
    pg8::StaticOrder S; S.init(32768, 1024, (int)gridDim.x, obid());
    pg8::gemm_phase<pg8::EpiRes<FIRST>, pg8::StaticOrder, true, true>((PG8_LAS unsigned char*)smem, g, S, pg8::EpiRes<FIRST>{&p}); }
  { const int c = obid(), ks = c >> 2;
    pg8::TailOrder TS{c, 4 * (K >> 8), 128};
    pg8::Gemm g{A + ks * 256, Bt + ks * 256, MP, 1024, 256, lda, K};
    pg8::gemm_phase<pg8::EpiSlab, pg8::TailOrder, true, true>((PG8_LAS unsigned char*)smem, g, TS, pg8::EpiSlab{(float*)(p.ws + OFF_SLAB), ks}); }
}

__global__ void __launch_bounds__(NT, 2) fwd_megakernel(Params p) {
  cg::grid_group grid = cg::this_grid();
  __shared__ __attribute__((aligned(16))) unsigned char smem[SMEM_BYTES];
  unsigned char* ws = p.ws;
  bf16_t* XN = (bf16_t*)(ws + OFF_XN); bf16_t* Z = (bf16_t*)(ws + OFF_Z); float* GATES = (float*)(ws + OFF_GATES);
  __shared__ uint4 xb_words;
  if (threadIdx.x == 0) xb_words = make_uint4(0u, 0u, 0u, 0u);
  unsigned* barw = (unsigned*)(ws + OFF_BAR);
  if (blockIdx.x == 0) { for (int i = threadIdx.x; i < XCD_BAR_WORDS; i += NT) barw[i] = 0u; if (threadIdx.x == 0) *(unsigned*)(ws + OFF_CTR) = 0u; }
  wconv(smem, p.ev_w_in, (bf16_t*)(ws + OFF_WINE), 1024, 5128, 5376, 1, 1);
  wconv(smem, p.ev_w_out, (bf16_t*)(ws + OFF_WOUTE), 2048, 1024, 1024, 0, 1);
  wconv(smem, p.w_ff1, (bf16_t*)(ws + OFF_FF1), 1024, 4096, 4096, 0, 2);
  wconv(smem, p.w_ff2, (bf16_t*)(ws + OFF_FF2), 4096, 1024, 1024, 0, 2);
  wconv(smem, p.od_w_in, (bf16_t*)(ws + OFF_WINO), 1024, 2216, 2304, 0, 1);
  wconv(smem, p.od_w_uq, (bf16_t*)(ws + OFF_WUQ), 384, 768, 768, 0, 1);
  wconv(smem, p.od_w_ukv, (bf16_t*)(ws + OFF_WUKV), 256, 1024, 1024, 0, 1);
  wconv(smem, p.od_w_out, (bf16_t*)(ws + OFF_WOUTO), 1024, 1024, 1024, 0, 1);
  wconv(smem, p.ev_w_ra, (bf16_t*)(ws + OFF_WRA), 128, 128, 128, 0, 8);
  wconv(smem, p.ev_w_rx, (bf16_t*)(ws + OFF_WRX), 128, 128, 128, 0, 8);
  norm_phase(p, p.ev_ln, 1, 0);
  grid.sync();
  (void)xcd_barrier_post(barw, (volatile LAS unsigned*)&xb_words);
#define GSYNC() do { XcdBarrier xb_; xb_.bar = (unsigned*)(p.ws + OFF_BAR); xb_.x = xb_xcc_id(); xb_.st = (volatile LAS unsigned*)&xb_words; xcd_barrier(xb_); } while (0)
  run_gemm(smem, XN, 1024, (const bf16_t*)(ws + OFF_WINE), 5376, 1024, pg8::EpiZ<0>{Z, LDZE, 5120, GATES});
  GSYNC();
  {
    const int G = (int)gridDim.x;
    for (int pr = obid(); pr < 128; pr += G) mlstm_item8(p, smem, pr);
    { const int b0 = obid();
      for (int pr = b0 >= 128 ? b0 : b0 + G * ((127 - b0) / G + 1); pr < 256; pr += G) rglru_item8(p, smem, pr - 128); }
  }
  GSYNC();
  anorm_phase(p);
  GSYNC();
  run_gemm_res<true>(p, smem, Z + 3072, LDZE, (const bf16_t*)(ws + OFF_WOUTE), 2048);
  GSYNC();
  for (int layer = 0; layer < 2; ++layer) {
    if (layer == 1) {
      norm_phase(p, p.od_ln, 0, 16);
      GSYNC();
      run_gemm(smem, XN, 1024, (const bf16_t*)(ws + OFF_WINO), 2304, 1024, pg8::EpiZ<0>{Z, LDZO, 2208, GATES});
      GSYNC();
      oddprep_phase(p);
      GSYNC();
      run_gemm(smem, Z, LDZO, (const bf16_t*)(ws + OFF_WUQ), 768, 384, pg8::EpiZ<0>{(bf16_t*)(ws + OFF_QRAW), 768, 1 << 30, nullptr});
      run_gemm(smem, Z + 384, LDZO, (const bf16_t*)(ws + OFF_WUKV), 1024, 256, pg8::EpiZ<0>{(bf16_t*)(ws + OFF_KVRAW), 1024, 1 << 30, nullptr});
      for (int it = obid(); it < 64; it += gridDim.x) fcum_item(p, smem, it);
      GSYNC();
      headprep_phase(p);
      GSYNC();
      attn_phase(p, smem);
      GSYNC();
      run_gemm_res<false>(p, smem, XN, 1024, (const bf16_t*)(ws + OFF_WOUTO), 1024);
      GSYNC();
    }
    norm_phase(p, p.mlp_ln + layer * 1024, layer ? 0 : 2, layer ? 4 : 8);
    GSYNC();
    run_gemm(smem, XN, 1024, (const bf16_t*)(ws + OFF_FF1) + (size_t)layer * 4096 * 1024, 4096, 1024, pg8::EpiZ<1>{Z, 4096, 1 << 30, nullptr});
    GSYNC();
    run_gemm_res<false>(p, smem, Z, 4096, (const bf16_t*)(ws + OFF_FF2) + (size_t)layer * 4096 * 1024, 4096);
    GSYNC();
  }
  {
    const int tid = otid(), lane = tid & 63, wave = (obid() * NT + tid) >> 6;
    if (wave < 128) { const int r = 32768 + wave; float* hp = hrow(p, r);
      const float* sl = (const float*)(ws + OFF_SLAB) + (size_t)wave * 1024 + lane * 4;
#pragma unroll
      for (int i = 0; i < 4; ++i) { float4 v = *(const float4*)(hp + i * 256 + lane * 4);
        for (int sI = 0; sI < 16; ++sI) { const float4 a = *(const float4*)(sl + (size_t)sI * 131072 + i * 256); v.x += a.x; v.y += a.y; v.z += a.z; v.w += a.w; }
        *(float4*)(hp + i * 256 + lane * 4) = v; } }
  }
}

extern "C" void kernel_launch(void* const* d_in, const int* in_sizes, int n_in, void* d_out, int out_size,
                              void* d_ws, size_t ws_size, hipStream_t stream) {
  static int grid_blocks = 0;
  if (!grid_blocks) {
    int dev = 0, cus = 0, per_cu = 0;
    (void)hipGetDevice(&dev);
    (void)hipDeviceGetAttribute(&cus, hipDeviceAttributeMultiprocessorCount, dev);
    (void)hipOccupancyMaxActiveBlocksPerMultiprocessor(&per_cu, fwd_megakernel, NT, 0);
    if (per_cu > 1) per_cu = 1;
    if (per_cu < 1) per_cu = 1;
    grid_blocks = cus * per_cu;
  }
  Params p{};
  const float** fp = (const float**)&p;
  (void)fp;
  p.x = (const float*)d_in[0]; p.pos = (const int*)d_in[1]; p.meta = (const float*)d_in[2];
  p.ev_ln = (const float*)d_in[3]; p.ev_w_in = (const float*)d_in[4]; p.ev_b_if = (const float*)d_in[5]; p.ev_a_norm = (const float*)d_in[6];
  p.ev_conv_w = (const float*)d_in[7]; p.ev_conv_b = (const float*)d_in[8]; p.ev_w_ra = (const float*)d_in[9]; p.ev_b_ra = (const float*)d_in[10];
  p.ev_w_rx = (const float*)d_in[11]; p.ev_b_rx = (const float*)d_in[12]; p.ev_lam = (const float*)d_in[13]; p.ev_w_out = (const float*)d_in[14];
  p.od_ln = (const float*)d_in[15]; p.od_w_in = (const float*)d_in[16]; p.od_b_f = (const float*)d_in[17]; p.od_g_qa = (const float*)d_in[18];
  p.od_g_kva = (const float*)d_in[19]; p.od_w_uq = (const float*)d_in[20]; p.od_w_ukv = (const float*)d_in[21]; p.od_g_qn = (const float*)d_in[22];
  p.od_g_qr = (const float*)d_in[23]; p.od_g_kn = (const float*)d_in[24]; p.od_g_kr = (const float*)d_in[25]; p.od_g_fq = (const float*)d_in[26];
  p.od_g_fk = (const float*)d_in[27]; p.od_w_out = (const float*)d_in[28];
  p.mlp_ln = (const float*)d_in[29]; p.w_ff1 = (const float*)d_in[30]; p.w_ff2 = (const float*)d_in[31];
  p.out = (float*)d_out; p.ws = (unsigned char*)d_ws;
  void* args[] = {&p};
  hipError_t e = hipLaunchCooperativeKernel((void*)fwd_megakernel, dim3(grid_blocks), dim3(NT), args, 0, stream);
  if (e != hipSuccess) fprintf(stderr, "cooperative launch failed: %s (grid %d)\n", hipGetErrorString(e), grid_blocks);
}
```
